# Optimizing an MI355X kernel written in HIP

```python
import math
import jax, jax.numpy as jnp
from jax import lax
import numpy as np

D_MODEL = 1024
BATCH = 8
SEQ = 2048
DEPTH = 1

N_HEADS_A = 8
HEAD_DIM_A = 64
V_DIM_A = 2 * HEAD_DIM_A
QK_WIDTH = N_HEADS_A * 2 * HEAD_DIM_A
ATTN_WIDTH = N_HEADS_A * V_DIM_A
Q_BLOCK = 128
N_GROUPS_B = 8
CHUNK = 128
GMLP_WIDTH = 1024
GROUP_DIM_B = GMLP_WIDTH // N_GROUPS_B
N_BUCKETS = 32
MAX_DISTANCE = 128
D_FF = 2816
N_SUBLAYERS = 3
N_BRANCHES = 2
EPS = 1e-6
COL_Q = 0
COL_K = COL_Q + QK_WIDTH
COL_V = COL_K + QK_WIDTH
COL_U = COL_V + ATTN_WIDTH
COL_GV = COL_U + GMLP_WIDTH
COL_GATE = COL_GV + GMLP_WIDTH
IN_COLS = COL_GATE + N_BRANCHES * D_MODEL

kernel_name = "hybrid_diffattn_gmlp_macaron_adaln"


def rmsnorm(x):
    xf = x.astype(jnp.float32)
    return (xf * lax.rsqrt(jnp.mean(xf * xf, axis=-1, keepdims=True) + EPS)).astype(x.dtype)


def layernorm(x, g, b):
    xf = x.astype(jnp.float32)
    mu = jnp.mean(xf, axis=-1, keepdims=True)
    var = jnp.mean(jnp.square(xf - mu), axis=-1, keepdims=True)
    return ((xf - mu) * lax.rsqrt(var + EPS)).astype(x.dtype) * g + b


def modulate(h, shift, scale):
    return h * (1.0 + scale[:, None, :]) + shift[:, None, :]


def swiglu(h, w_gate, w_up, w_down):
    return (jax.nn.silu(h @ w_gate) * (h @ w_up)) @ w_down


def rel_bucket(q_pos, k_pos):
    n = jnp.maximum(q_pos[:, None] - k_pos[None, :], 0)
    max_exact = N_BUCKETS // 2
    nf = jnp.maximum(n, 1).astype(jnp.float32)
    large = max_exact + (jnp.log(nf / max_exact) / math.log(MAX_DISTANCE / max_exact)
                         * (N_BUCKETS - max_exact)).astype(jnp.int32)
    large = jnp.minimum(large, N_BUCKETS - 1)
    return jnp.where(n < max_exact, n, large)


def diff_attention(q, k, v, rel_table, q_g, k_g, lam, lam_init, sub_g):
    b, s = q.shape[0], q.shape[1]
    q = rmsnorm(q) * q_g
    k = rmsnorm(k) * k_g
    scale = HEAD_DIM_A ** -0.5
    outs = []
    for i in range(s // Q_BLOCK):
        q0 = i * Q_BLOCK
        kv_len = q0 + Q_BLOCK
        qb = q[:, q0:kv_len]
        kb = k[:, :kv_len]
        vb = v[:, :kv_len]
        logits = jnp.einsum('bqhmd,bkhmd->bhmqk', qb, kb).astype(jnp.float32) * scale
        q_pos = q0 + jnp.arange(Q_BLOCK)
        k_pos = jnp.arange(kv_len)
        bias = jnp.transpose(rel_table[rel_bucket(q_pos, k_pos)], (2, 0, 1)).astype(jnp.float32)
        logits = logits + bias[None, :, None]
        mask = k_pos[None, :] <= q_pos[:, None]
        logits = jnp.where(mask, logits, -jnp.inf)
        p = jax.nn.softmax(logits, axis=-1)
        attn = p[:, :, 0] - lam * p[:, :, 1]
        outs.append(jnp.einsum('bhqk,bkhe->bqhe', attn.astype(vb.dtype), vb))
    o = jnp.concatenate(outs, axis=1)
    o = rmsnorm(o) * sub_g * (1.0 - lam_init)
    return o.reshape(b, s, ATTN_WIDTH)


def spatial_gating(u, v, ln_g, ln_b, w_s, b_s):
    b, s = u.shape[0], u.shape[1]
    v = layernorm(v, ln_g, ln_b)
    vc = v.reshape(b, s // CHUNK, CHUNK, N_GROUPS_B, GROUP_DIM_B)
    tri = jnp.tril(jnp.ones((CHUNK, CHUNK), dtype=bool))
    w = jnp.where(tri[None], w_s, jnp.zeros_like(w_s))
    f = jnp.einsum('gts,bnsgc->bntgc', w, vc) + jnp.transpose(b_s)[None, None, :, :, None]
    return u * f.reshape(b, s, GMLP_WIDTH)


def setup_inputs(seed: int = 0) -> dict:
    key = jax.random.key(seed)
    ks = jax.random.split(key, 32)
    f32 = jnp.float32
    L, D = DEPTH, D_MODEL

    def nrm(k, shape, fan_in):
        return jax.random.normal(k, shape, f32) * (fan_in ** -0.5)

    def gain(k, shape):
        return 1.0 + 0.05 * jax.random.normal(k, shape, f32)

    return {
        "x": jax.random.normal(ks[0], (BATCH, SEQ, D), f32),
        "c": jax.random.normal(ks[1], (BATCH, D), f32),
        "w_ada": nrm(ks[2], (L, D, N_SUBLAYERS * 3 * D), D) * 0.5,
        "b_ada": 0.02 * jax.random.normal(ks[3], (L, N_SUBLAYERS * 3 * D), f32),
        "w_ffn1_gate": nrm(ks[4], (L, D, D_FF), D),
        "w_ffn1_up": nrm(ks[5], (L, D, D_FF), D),
        "w_ffn1_down": nrm(ks[6], (L, D_FF, D), D_FF),
        "w_in": nrm(ks[7], (L, D, IN_COLS), D),
        "q_norm_g": gain(ks[8], (L, HEAD_DIM_A)),
        "k_norm_g": gain(ks[9], (L, HEAD_DIM_A)),
        "lam_q1": 0.1 * jax.random.normal(ks[10], (L, HEAD_DIM_A), f32),
        "lam_k1": 0.1 * jax.random.normal(ks[11], (L, HEAD_DIM_A), f32),
        "lam_q2": 0.1 * jax.random.normal(ks[12], (L, HEAD_DIM_A), f32),
        "lam_k2": 0.1 * jax.random.normal(ks[13], (L, HEAD_DIM_A), f32),
        "subln_g": gain(ks[14], (L, V_DIM_A)),
        "rel_bias_table": 0.5 * jax.random.normal(ks[15], (N_BUCKETS, N_HEADS_A), f32),
        "gmlp_ln_g": gain(ks[16], (L, GMLP_WIDTH)),
        "gmlp_ln_b": 0.02 * jax.random.normal(ks[17], (L, GMLP_WIDTH), f32),
        "w_spatial": nrm(ks[18], (L, N_GROUPS_B, CHUNK, CHUNK), CHUNK),
        "b_spatial": 1.0 + 0.05 * jax.random.normal(ks[19], (L, N_GROUPS_B, CHUNK), f32),
        "w_a_proj": nrm(ks[20], (L, ATTN_WIDTH, D), ATTN_WIDTH),
        "w_b_proj": nrm(ks[21], (L, GMLP_WIDTH, D), GMLP_WIDTH),
        "w_o": nrm(ks[22], (L, D, D), D),
        "w_ffn2_gate": nrm(ks[23], (L, D, D_FF), D),
        "w_ffn2_up": nrm(ks[24], (L, D, D_FF), D),
        "w_ffn2_down": nrm(ks[25], (L, D_FF, D), D_FF),
    }


def reference(x, c, w_ada, b_ada, w_ffn1_gate, w_ffn1_up, w_ffn1_down, w_in,
              q_norm_g, k_norm_g, lam_q1, lam_k1, lam_q2, lam_k2, subln_g,
              rel_bias_table, gmlp_ln_g, gmlp_ln_b, w_spatial, b_spatial,
              w_a_proj, w_b_proj, w_o, w_ffn2_gate, w_ffn2_up, w_ffn2_down):
    b, s, d = x.shape
    for l in range(DEPTH):
        lam_init = 0.8 - 0.6 * math.exp(-0.3 * l)
        mod = (jax.nn.silu(c) @ w_ada[l] + b_ada[l]).reshape(b, N_SUBLAYERS * 3, d)
        sh0, sc0, g0, sh1, sc1, g1, sh2, sc2, g2 = [mod[:, j] for j in range(N_SUBLAYERS * 3)]

        h = modulate(rmsnorm(x), sh0, sc0)
        x = x + 0.5 * g0[:, None, :] * swiglu(h, w_ffn1_gate[l], w_ffn1_up[l], w_ffn1_down[l])

        h = modulate(rmsnorm(x), sh1, sc1)
        proj = h @ w_in[l]
        q = proj[..., COL_Q:COL_K].reshape(b, s, N_HEADS_A, 2, HEAD_DIM_A)
        k = proj[..., COL_K:COL_V].reshape(b, s, N_HEADS_A, 2, HEAD_DIM_A)
        v = proj[..., COL_V:COL_U].reshape(b, s, N_HEADS_A, V_DIM_A)
        gu = jax.nn.gelu(proj[..., COL_U:COL_GV], approximate=False)
        gv = jax.nn.gelu(proj[..., COL_GV:COL_GATE], approximate=False)
        gates = jax.nn.sigmoid(proj[..., COL_GATE:].astype(jnp.float32)).astype(x.dtype)
        gates = gates.reshape(b, s, N_BRANCHES, d)

        lam = (jnp.exp(jnp.sum(lam_q1[l].astype(jnp.float32) * lam_k1[l].astype(jnp.float32)))
               - jnp.exp(jnp.sum(lam_q2[l].astype(jnp.float32) * lam_k2[l].astype(jnp.float32)))
               + lam_init)
        y_a = diff_attention(q, k, v, rel_bias_table, q_norm_g[l], k_norm_g[l], lam,
                             lam_init, subln_g[l]) @ w_a_proj[l]
        y_b = spatial_gating(gu, gv, gmlp_ln_g[l], gmlp_ln_b[l], w_spatial[l],
                             b_spatial[l]) @ w_b_proj[l]
        merged = gates[:, :, 0] * y_a + gates[:, :, 1] * y_b
        x = x + g1[:, None, :] * (merged @ w_o[l])

        h = modulate(rmsnorm(x), sh2, sc2)
        x = x + 0.5 * g2[:, None, :] * swiglu(h, w_ffn2_gate[l], w_ffn2_up[l], w_ffn2_down[l])
    return x
```

```cpp
#include <hip/hip_runtime.h>
#include <cstdio>
#include <cstdint>
namespace pg8 {
#define PG8_LAS __attribute__((address_space(3)))
typedef unsigned short bf16_t;
typedef short bf16x8 __attribute__((ext_vector_type(8)));
typedef float f32x4 __attribute__((ext_vector_type(4)));
typedef unsigned u32x4 __attribute__((ext_vector_type(4)));
constexpr int BM = 256, BK = 64, HALF = 128, HTB = HALF * BK * 2  , STAGE_BYTES = 8 * HTB, NXCD = 8, WGM = 8;

__host__ __device__ __forceinline__ int lds_byte(int r, int c) { const int st = (r >> 4) * 2 + (c >> 5), rr = r & 15, cc = c & 31, ob = rr * 64 + cc * 2; return st * 1024 + (ob ^ (((ob >> 9) & 1) << 5)); }
__host__ __device__ __forceinline__ void stage_rc(int b, int& R, int& C) { const int st = b / 1024, sb = b % 1024, swz = sb ^ (((sb >> 9) & 1) << 5); R = (st >> 1) * 16 + swz / 64; C = (st & 1) * 32 + (swz % 64) / 2; }
__host__ __device__ __forceinline__ int perm32(int rho) { const int n = rho >> 4, i = rho & 15; return 8 * (i >> 2) + 4 * n + (i & 3); }

struct Unit { int pm, pn; };
struct Gemm { const bf16_t* A; const bf16_t* Bt; int M, N, K; };

struct StaticOrder {
    int nM, nN, nwg, G, c;
    __host__ __device__ void init(int M, int N, int G_, int c_) { nM = M / BM; nN = N / BM; nwg = nM * nN; G = G_; c = c_; }
    __host__ __device__ bool next(int i, Unit& u) const {
        const long L = (long)i * G + c; if (L >= nwg) return false;
        int wgid = (int)L; { const int q = nwg / NXCD, r = nwg % NXCD, xcd = wgid % NXCD, off = wgid / NXCD; wgid = (xcd < r ? xcd * (q + 1) : r * (q + 1) + (xcd - r) * q) + off; }
        const int nig = WGM * nN, gid = wgid / nig, fm = gid * WGM, gsz = (nM - fm) < WGM ? (nM - fm) : WGM;
        u.pm = fm + ((wgid % nig) % gsz); u.pn = (wgid % nig) / gsz; return true;
    }
    __device__ __forceinline__ void a_ready(const Unit&) const {}
    __device__ __forceinline__ void done(const Unit&) const {}
};

typedef float cvt_f32x2_t __attribute__((ext_vector_type(2))); typedef __bf16 cvt_bf16x2_t __attribute__((ext_vector_type(2)));
__device__ __forceinline__ unsigned cvt_pk_bf16(float lo, float hi) { cvt_f32x2_t v = {lo, hi}; cvt_bf16x2_t b = __builtin_convertvector(v, cvt_bf16x2_t); return __builtin_bit_cast(unsigned, b); }
typedef float f32x2 __attribute__((ext_vector_type(2)));
__device__ __forceinline__ f32x2 gelu_pk(f32x2 v) {
    const f32x2 av = __builtin_elementwise_abs(v), d = av * 0.2316418882f + 1.0f;
    f32x2 t; t.x = __builtin_amdgcn_rcpf(d.x); t.y = __builtin_amdgcn_rcpf(d.y);
    f32x2 q = t * 0.5307027145f + (-0.7265760135f); q = q * t + 0.7107068705f; q = q * t + (-0.142248368f); q = q * t + 0.127414796f; q = q * t;
    const f32x2 s = (v * v) * (-0.72134752044f);
    f32x2 e; e.x = __builtin_amdgcn_exp2f(s.x); e.y = __builtin_amdgcn_exp2f(s.y);
    const f32x2 m = v * (q * e), r = v - m;
    f32x2 o; o.x = v.x < 0.f ? m.x : r.x; o.y = v.y < 0.f ? m.y : r.y; return o;
}

__device__ __forceinline__ float bf2f(unsigned short h) { return __uint_as_float((unsigned)h << 16); }
__device__ __forceinline__ float bflo(unsigned w) { return __uint_as_float(w << 16); }
__device__ __forceinline__ float bfhi(unsigned w) { return __uint_as_float(w & 0xffff0000u); }
__device__ __forceinline__ float sigmoidf_fast(float x) { return __builtin_amdgcn_rcpf(1.0f + __builtin_amdgcn_exp2f(-1.4426950408889634f * x)); }
__device__ __forceinline__ u32x4 pack8(const f32x4& v0, const f32x4& v1) { u32x4 w; w.x = cvt_pk_bf16(v0[0], v0[1]); w.y = cvt_pk_bf16(v0[2], v0[3]); w.z = cvt_pk_bf16(v1[0], v1[1]); w.w = cvt_pk_bf16(v1[2], v1[3]); return w; }

struct EpiSwiGLU {
    static constexpr bool PERM = true, AFTER_DRAIN = false;
    bf16_t* H; int ldh;
    __device__ __forceinline__ void operator()(const f32x4 (&acc)[2][2][4][2], const Unit& u, int wr, int wc, int fr, int fq) const {
        const int row0 = u.pm * BM + wr * 64 + fr, col0 = u.pn * HALF + wc * 32 + 8 * fq;
#pragma unroll
        for (int ai = 0; ai < 2; ++ai)
#pragma unroll
            for (int m = 0; m < 4; ++m) { bf16_t* rowp = H + (size_t)(row0 + ai * HALF + m * 16) * ldh + col0;
                f32x4 h0, h1;
#pragma unroll
                for (int j = 0; j < 4; ++j) { const float g0 = acc[ai][0][m][0][j], g1 = acc[ai][0][m][1][j];
                    h0[j] = g0 * sigmoidf_fast(g0) * acc[ai][1][m][0][j]; h1[j] = g1 * sigmoidf_fast(g1) * acc[ai][1][m][1][j]; }
                *(u32x4*)rowp = pack8(h0, h1); }
    }
};
struct EpiResGate {
    static constexpr bool PERM = false, AFTER_DRAIN = false;
    const float* base; float* out; const float* mod; int gidx; float coef;
    __device__ __forceinline__ void operator()(const f32x4 (&acc)[2][2][4][2], const Unit& u, int wr, int wc, int fr, int fq) const {
        const int row0 = u.pm * BM + wr * 64 + fr, col0 = u.pn * BM + wc * 32 + 4 * fq;
        const float* gate = mod + (size_t)(u.pm >> 3) * 9216 + gidx * 1024 + col0;
        f32x4 gv[2][2];
#pragma unroll
        for (int bj = 0; bj < 2; ++bj)
#pragma unroll
            for (int n = 0; n < 2; ++n) gv[bj][n] = *(const f32x4*)(gate + bj * HALF + n * 16) * coef;
#pragma unroll
        for (int ai = 0; ai < 2; ++ai)
#pragma unroll
            for (int m = 0; m < 4; ++m) { const size_t off = (size_t)(row0 + ai * HALF + m * 16) * 1024 + col0;
#pragma unroll
                for (int bj = 0; bj < 2; ++bj)
#pragma unroll
                    for (int n = 0; n < 2; ++n) { const f32x4 bs = *(const f32x4*)(base + off + bj * HALF + n * 16); *(f32x4*)(out + off + bj * HALF + n * 16) = bs + gv[bj][n] * acc[ai][bj][m][n]; }
                asm volatile("" ::: "memory"); }
    }
};
struct EpiInA {
    static constexpr bool PERM = true, AFTER_DRAIN = false;
    bf16_t *Q, *K, *V, *U, *GV;
    __device__ __forceinline__ void operator()(const f32x4 (&acc)[2][2][4][2], const Unit& u, int wr, int wc, int fr, int fq) const {
        const int row0 = u.pm * BM + wr * 64 + fr, ty = u.pn >> 2, pq = u.pn & 3;
        bf16_t* base = ty == 0 ? Q : ty == 1 ? K : ty == 2 ? V : ty == 3 ? U : GV;
        const bool qk = ty < 2, act = ty >= 3;
#pragma unroll
        for (int ai = 0; ai < 2; ++ai)
#pragma unroll
            for (int m = 0; m < 4; ++m) { bf16_t* rowp = base + (size_t)(row0 + ai * HALF + m * 16) * 1024 + pq * BM;
#pragma unroll
                for (int bj = 0; bj < 2; ++bj) { f32x4 v0 = acc[ai][bj][m][0], v1 = acc[ai][bj][m][1];
                    if (act) { f32x2 a = gelu_pk((f32x2){v0[0], v0[1]}), b = gelu_pk((f32x2){v0[2], v0[3]}), c = gelu_pk((f32x2){v1[0], v1[1]}), d = gelu_pk((f32x2){v1[2], v1[3]});
                        v0 = (f32x4){a.x, a.y, b.x, b.y}; v1 = (f32x4){c.x, c.y, d.x, d.y}; }
                    const int col = qk ? (64 * wc + 32 * bj + 8 * fq) : (HALF * bj + 32 * wc + 8 * fq);
                    *(u32x4*)(rowp + col) = pack8(v0, v1); } }
    }
};
struct EpiGate {
    static constexpr bool PERM = true, AFTER_DRAIN = false;
    bf16_t *GA, *GB;
    __device__ __forceinline__ void operator()(const f32x4 (&acc)[2][2][4][2], const Unit& u, int wr, int wc, int fr, int fq) const {
        const int row0 = u.pm * BM + wr * 64 + fr, pq = u.pn & 3;
        bf16_t* base = (u.pn >> 2) ? GB : GA;
#pragma unroll
        for (int ai = 0; ai < 2; ++ai)
#pragma unroll
            for (int m = 0; m < 4; ++m) { bf16_t* rowp = base + (size_t)(row0 + ai * HALF + m * 16) * 1024 + pq * BM + 32 * wc + 8 * fq;
#pragma unroll
                for (int bj = 0; bj < 2; ++bj) { f32x4 v0 = acc[ai][bj][m][0], v1 = acc[ai][bj][m][1];
#pragma unroll
                    for (int j = 0; j < 4; ++j) { v0[j] = sigmoidf_fast(v0[j]); v1[j] = sigmoidf_fast(v1[j]); }
                    *(u32x4*)(rowp + HALF * bj) = pack8(v0, v1); } }
    }
};
template <bool ADD> struct EpiProj {
    static constexpr bool PERM = true, AFTER_DRAIN = false;
    const bf16_t* G; bf16_t* MG; float dbg;
    __device__ __forceinline__ void operator()(const f32x4 (&acc)[2][2][4][2], const Unit& u, int wr, int wc, int fr, int fq) const {
        const int row0 = u.pm * BM + wr * 64 + fr, col0 = u.pn * BM + 32 * wc + 8 * fq;
#pragma unroll
        for (int ai = 0; ai < 2; ++ai)
#pragma unroll
            for (int m = 0; m < 4; ++m) { const size_t off = (size_t)(row0 + ai * HALF + m * 16) * 1024 + col0;
#pragma unroll
                for (int bj = 0; bj < 2; ++bj) { const u32x4 g = *(const u32x4*)(G + off + HALF * bj);
                    f32x4 v0 = acc[ai][bj][m][0], v1 = acc[ai][bj][m][1];
                    v0 = v0 * dbg; v1 = v1 * dbg; v0[0] *= bflo(g.x); v0[1] *= bfhi(g.x); v0[2] *= bflo(g.y); v0[3] *= bfhi(g.y); v1[0] *= bflo(g.z); v1[1] *= bfhi(g.z); v1[2] *= bflo(g.w); v1[3] *= bfhi(g.w);
                    if (ADD) { const u32x4 p = *(const u32x4*)(MG + off + HALF * bj);
                        v0[0] += bflo(p.x); v0[1] += bfhi(p.x); v0[2] += bflo(p.y); v0[3] += bfhi(p.y); v1[0] += bflo(p.z); v1[1] += bfhi(p.z); v1[2] += bflo(p.w); v1[3] += bfhi(p.w); }
                    *(u32x4*)(MG + off + HALF * bj) = pack8(v0, v1); } }
    }
};

template <class Epi, class Sched, bool ALIGN_EPI = false, bool SP2 = false>
__device__ __forceinline__ void gemm_phase(PG8_LAS unsigned char* lds, const Gemm g, const Sched& S, const Epi& E) {
    const int tid = threadIdx.x, wid = __builtin_amdgcn_readfirstlane(tid >> 6), lane = tid & 63, wr = wid >> 2, wc = wid & 3, fr = lane & 15, fq = lane >> 4;
    const int K = g.K, nt = K / BK;
    unsigned voffA[2], voffB[2];
#pragma unroll
    for (int i = 0; i < 2; ++i) { int R, C; stage_rc(tid * 16 + i * 8192, R, C); const int Rb = Epi::PERM ? ((R & ~31) + perm32(R & 31)) : R;
        voffA[i] = (unsigned)(R * K + C) * 2u; voffB[i] = (unsigned)(Rb * K + C) * 2u; }
    const size_t kstep = (size_t)(BK * 2);
    const size_t hstep = (size_t)HALF * K * 2;
    const size_t tstep = 2 * hstep;
    const unsigned ldsw = (unsigned)wid * 1024u;
    const int aoff = lds_byte(wr * 64 + fr, fq * 8), boff = lds_byte(wc * 32 + fr, fq * 8);
#define PG8_SA(b, h) (((b) * 2 + (h)) * HTB)
#define PG8_SB(b, h) ((4 + (b) * 2 + (h)) * HTB)
#define PG8_STAGE(bufoff, gbase, voff) do { _Pragma("unroll") for (int _i = 0; _i < 2; ++_i) \
        __builtin_amdgcn_global_load_lds((const unsigned*)((const char*)(gbase) + (voff)[_i]), (PG8_LAS unsigned*)(lds + (bufoff) + ldsw + _i * 8192), 16, 0, 0); } while (0)
#define PG8_LDA(dst, b, h) do { _Pragma("unroll") for (int m = 0; m < 4; ++m) _Pragma("unroll") for (int k = 0; k < 2; ++k) dst[m][k] = *(const PG8_LAS bf16x8*)(lds + PG8_SA(b, h) + aoff + m * 2048 + k * 1024); } while (0)
#define PG8_LDB(dst, b, h) do { _Pragma("unroll") for (int n = 0; n < 2; ++n) _Pragma("unroll") for (int k = 0; k < 2; ++k) dst[n][k] = *(const PG8_LAS bf16x8*)(lds + PG8_SB(b, h) + boff + n * 2048 + k * 1024); } while (0)
#define PG8_MMA(ai, bj, At, Bt) do { __builtin_amdgcn_s_setprio(1); _Pragma("unroll") for (int m = 0; m < 4; ++m) _Pragma("unroll") for (int n = 0; n < 2; ++n) _Pragma("unroll") for (int k = 0; k < 2; ++k) \
        acc[ai][bj][m][n] = __builtin_amdgcn_mfma_f32_16x16x32_bf16(Bt[n][k], At[m][k], acc[ai][bj][m][n], 0, 0, 0); __builtin_amdgcn_s_setprio(0); } while (0)
#define PG8_WAIT_V(n) asm volatile("s_waitcnt vmcnt(" #n ")" ::: "memory")
#define PG8_WAIT_L(n) asm volatile("s_waitcnt lgkmcnt(" #n ")" ::: "memory")
#define PG8_BAR __builtin_amdgcn_s_barrier()
#define PG8_SCHED __builtin_amdgcn_sched_barrier(0)
    Unit cur, nxt; int ui = 0;
    if (!S.next(0, cur)) return;
    f32x4 acc[2][2][4][2];
#pragma unroll
    for (int a = 0; a < 2; ++a)
#pragma unroll
        for (int b = 0; b < 2; ++b)
#pragma unroll
            for (int m = 0; m < 4; ++m)
#pragma unroll
                for (int n = 0; n < 2; ++n) acc[a][b][m][n] = (f32x4){0.f, 0.f, 0.f, 0.f};
    bf16x8 At[4][2], B0[2][2], B1[2][2];
    const char* cA = (const char*)g.A + (size_t)cur.pm * tstep; const char* cB = (const char*)g.Bt + (size_t)cur.pn * tstep;
    S.a_ready(cur);
    if constexpr (SP2) {
        PG8_STAGE(PG8_SB(0, 0), cB, voffB); PG8_STAGE(PG8_SB(0, 1), cB + hstep, voffB); PG8_STAGE(PG8_SA(0, 0), cA, voffA); PG8_STAGE(PG8_SA(0, 1), cA + hstep, voffA);
        if (wr == 1) PG8_BAR;
        PG8_WAIT_V(2); PG8_BAR;
        PG8_STAGE(PG8_SB(1, 0), cB + kstep, voffB); PG8_STAGE(PG8_SA(1, 0), cA + kstep, voffA); PG8_STAGE(PG8_SB(1, 1), cB + hstep + kstep, voffB);
        PG8_WAIT_V(6); PG8_BAR;
    } else {
        PG8_STAGE(PG8_SB(0, 0), cB, voffB); PG8_STAGE(PG8_SA(0, 0), cA, voffA); PG8_STAGE(PG8_SB(0, 1), cB + hstep, voffB); PG8_STAGE(PG8_SA(0, 1), cA + hstep, voffA);
        if (wr == 1) PG8_BAR;
        PG8_WAIT_V(4); PG8_BAR;
        PG8_STAGE(PG8_SB(1, 0), cB + kstep, voffB); PG8_STAGE(PG8_SA(1, 0), cA + kstep, voffA); PG8_STAGE(PG8_SB(1, 1), cB + hstep + kstep, voffB);
        PG8_WAIT_V(6); PG8_BAR;
    }
    for (;;) {
        const bool has_next = S.next(ui + 1, nxt);
        const char* nA = has_next ? (const char*)g.A + (size_t)nxt.pm * tstep : cA; const char* nB = has_next ? (const char*)g.Bt + (size_t)nxt.pn * tstep : cB;
        for (int t = 0; t < nt; t += 2) {
            const bool last = (t == nt - 2);
            const char* a1 = cA + (size_t)(t + 1) * kstep;
            const char* a2 = last ? nA : cA + (size_t)(t + 2) * kstep; const char* b2 = last ? nB : cB + (size_t)(t + 2) * kstep;
            const char* a3 = a2 + kstep; const char* b3 = b2 + kstep;
            if (last && has_next) S.a_ready(nxt);
            if constexpr (SP2) {
            PG8_LDB(B0, 0, 0); PG8_LDB(B1, 0, 1); PG8_SCHED; PG8_LDA(At, 0, 0); PG8_STAGE(PG8_SA(1, 1), a1 + hstep, voffA);
            PG8_WAIT_V(8); PG8_WAIT_L(0); PG8_BAR; PG8_MMA(0, 0, At, B0); PG8_MMA(0, 1, At, B1); PG8_BAR; PG8_SCHED;
            PG8_LDA(At, 0, 1); PG8_STAGE(PG8_SB(0, 0), b2, voffB); PG8_STAGE(PG8_SB(0, 1), b2 + hstep, voffB); PG8_STAGE(PG8_SA(0, 0), a2, voffA);
            PG8_WAIT_V(8); PG8_WAIT_L(0); PG8_BAR; PG8_MMA(1, 0, At, B0); PG8_MMA(1, 1, At, B1); PG8_BAR; PG8_SCHED;
            PG8_LDB(B0, 1, 0); PG8_LDB(B1, 1, 1); PG8_SCHED; PG8_LDA(At, 1, 0); PG8_STAGE(PG8_SA(0, 1), a2 + hstep, voffA);
            PG8_WAIT_V(8); PG8_WAIT_L(0); PG8_BAR; PG8_MMA(0, 0, At, B0); PG8_MMA(0, 1, At, B1); PG8_BAR; PG8_SCHED;
            PG8_LDA(At, 1, 1); PG8_STAGE(PG8_SB(1, 0), b3, voffB); PG8_STAGE(PG8_SB(1, 1), b3 + hstep, voffB); PG8_STAGE(PG8_SA(1, 0), a3, voffA);
            PG8_WAIT_V(8); PG8_WAIT_L(0); PG8_BAR; PG8_MMA(1, 0, At, B0); PG8_MMA(1, 1, At, B1); PG8_BAR; PG8_SCHED;
            } else {
            PG8_LDB(B0, 0, 0); PG8_SCHED; PG8_LDA(At, 0, 0); PG8_STAGE(PG8_SA(1, 1), a1 + hstep, voffA);
            PG8_WAIT_L(8); PG8_BAR; PG8_WAIT_L(0); PG8_MMA(0, 0, At, B0); PG8_BAR; PG8_SCHED;
            PG8_LDB(B1, 0, 1); PG8_STAGE(PG8_SB(0, 0), b2, voffB);
            PG8_BAR; PG8_WAIT_L(0); PG8_MMA(0, 1, At, B1); PG8_BAR;
            PG8_LDA(At, 0, 1); PG8_STAGE(PG8_SA(0, 0), a2, voffA);
            PG8_BAR; PG8_WAIT_L(0); PG8_MMA(1, 0, At, B0); PG8_BAR; PG8_SCHED;
            PG8_STAGE(PG8_SB(0, 1), b2 + hstep, voffB);
            PG8_WAIT_V(6); PG8_BAR; PG8_MMA(1, 1, At, B1); PG8_BAR;
            PG8_LDB(B0, 1, 0); PG8_SCHED; PG8_LDA(At, 1, 0); PG8_STAGE(PG8_SA(0, 1), a2 + hstep, voffA);
            PG8_WAIT_L(8); PG8_BAR; PG8_WAIT_L(0); PG8_MMA(0, 0, At, B0); PG8_BAR; PG8_SCHED;
            PG8_LDB(B1, 1, 1); PG8_STAGE(PG8_SB(1, 0), b3, voffB);
            PG8_BAR; PG8_WAIT_L(0); PG8_MMA(0, 1, At, B1); PG8_BAR;
            PG8_LDA(At, 1, 1); PG8_STAGE(PG8_SA(1, 0), a3, voffA);
            PG8_BAR; PG8_WAIT_L(0); PG8_MMA(1, 0, At, B0); PG8_BAR; PG8_SCHED;
            PG8_STAGE(PG8_SB(1, 1), b3 + hstep, voffB);
            PG8_WAIT_V(6); PG8_BAR; PG8_MMA(1, 1, At, B1); PG8_BAR;
            }
        }
        if constexpr (ALIGN_EPI) { if (wr == 0) PG8_BAR; }
        if constexpr (!Epi::AFTER_DRAIN) { E(acc, cur, wr, wc, fr, fq); S.done(cur); }
        if (!has_next) break;
#pragma unroll
        for (int a = 0; a < 2; ++a)
#pragma unroll
            for (int b = 0; b < 2; ++b)
#pragma unroll
                for (int m = 0; m < 4; ++m)
#pragma unroll
                    for (int n = 0; n < 2; ++n) acc[a][b][m][n] = (f32x4){0.f, 0.f, 0.f, 0.f};
        cur = nxt; cA = nA; cB = nB; ++ui;
        if constexpr (ALIGN_EPI) { if (wr == 1) PG8_BAR; }
    }
    PG8_WAIT_V(0);
    if constexpr (!ALIGN_EPI) { if (wr == 0) PG8_BAR; }
    PG8_BAR;
    if constexpr (Epi::AFTER_DRAIN) { E.fused(acc, cur, wr, wc, fr, fq, lds, wid, lane); S.done(cur); }
#undef PG8_SA
#undef PG8_SB
#undef PG8_STAGE
#undef PG8_LDA
#undef PG8_LDB
#undef PG8_MMA
#undef PG8_WAIT_V
#undef PG8_WAIT_L
#undef PG8_BAR
#undef PG8_SCHED
}
}

#ifndef PG8_SP2
#define PG8_SP2 true
#endif
#ifndef PG8_ALIGN
#define PG8_ALIGN true
#endif
#define GAS __attribute__((address_space(1)))
#define LAS __attribute__((address_space(3)))
typedef unsigned short bf16;
typedef unsigned v4u __attribute__((ext_vector_type(4)));
typedef float f32x4 __attribute__((ext_vector_type(4)));
typedef short bf16x8 __attribute__((ext_vector_type(8)));
typedef GAS unsigned gu32;
typedef GAS unsigned long long gu64;
#define RLX_AGENT __ATOMIC_RELAXED, __HIP_MEMORY_SCOPE_AGENT
#define LDS_WAIT() asm volatile("s_waitcnt lgkmcnt(0)" ::: "memory")
#define VM_WAIT() asm volatile("s_waitcnt vmcnt(0)" ::: "memory")
__device__ __forceinline__ unsigned long long rt() { return __builtin_amdgcn_s_memrealtime(); }
__device__ __forceinline__ unsigned f2bf(float f) { unsigned u = __builtin_bit_cast(unsigned, f); return (u + 0x7fffu + ((u >> 16) & 1u)) >> 16; }
__device__ __forceinline__ unsigned pk2(float lo, float hi) { return f2bf(lo) | (f2bf(hi) << 16); }

#define XB_TMO      128
#define XB_XCNT(j)  (256  + 64 * (j))
#define XB_XSUB(j)  (1280 + 64 * (j))
#define XB_XGEN(j)  (2304 + 64 * (j))
#define XB_TOP      3328
#define XB_TOPGEN   3392
#define XCD_BAR_WORDS 3456
#define XB_SPIN_CAP (1u << 18)

__device__ __forceinline__ unsigned xb_ld(unsigned* p)              { return __hip_atomic_load(p, __ATOMIC_RELAXED, __HIP_MEMORY_SCOPE_AGENT); }
__device__ __forceinline__ unsigned xb_add(unsigned* p, unsigned v) { return __hip_atomic_fetch_add(p, v, __ATOMIC_RELAXED, __HIP_MEMORY_SCOPE_AGENT); }
__device__ __forceinline__ unsigned xb_xcc_id() { return (unsigned)__builtin_amdgcn_s_getreg((3 << 11) | 20) & 0xFu; }
#define XB_SPIN(cond, bar) do { unsigned _sp = 0; while (cond) { __builtin_amdgcn_s_sleep(1); \
    if ((++_sp & 255u) == 0u) { if (xb_ld(&(bar)[XB_TMO])) break; if (_sp > XB_SPIN_CAP) { atomicAdd(&(bar)[XB_TMO], 1u); break; } } } } while (0)

struct XcdBarrier {
    unsigned* bar; unsigned x;
    volatile LAS unsigned* st;
};

__device__ __forceinline__ XcdBarrier xcd_barrier_post(unsigned* bar, volatile LAS unsigned* st) {
    XcdBarrier b; b.bar = bar; b.x = xb_xcc_id(); b.st = st;
    if (threadIdx.x == 0) (void)xb_add(&bar[XB_XCNT(b.x)], 1u);
    return b;
}
__device__ __forceinline__ void xcd_barrier_complete(unsigned* bar, unsigned x, unsigned& nloc, unsigned& nx) {
    const unsigned G = gridDim.x * gridDim.y * gridDim.z;
    unsigned sum, cnt, mine, sp = 0u;
    for (;;) {
        sum = 0u; cnt = 0u; mine = 0u;
#pragma unroll
        for (unsigned j = 0; j < 16; ++j) { const unsigned c = xb_ld(&bar[XB_XCNT(j)]); sum += c; cnt += (c > 0u) ? 1u : 0u; mine = (j == x) ? c : mine; }
        if (sum == G) break;
        __builtin_amdgcn_s_sleep(1);
        if ((++sp & 255u) == 0u) { if (xb_ld(&bar[XB_TMO])) break; if (sp > XB_SPIN_CAP) { atomicAdd(&bar[XB_TMO], 1u); break; } }
    }
    nloc = mine > 0u ? mine : 1u; nx = cnt > 0u ? cnt : 1u;
}

__device__ __forceinline__ void xcd_barrier(const XcdBarrier& b) {
    asm volatile("s_waitcnt vmcnt(0)" ::: "memory");
    __syncthreads();
    if (threadIdx.x == 0) {
        unsigned* bar = b.bar;
        __builtin_amdgcn_s_waitcnt(0);
        unsigned nloc = b.st[0], nx = b.st[1];
        if (nloc == 0u) { xcd_barrier_complete(bar, b.x, nloc, nx); b.st[0] = nloc; b.st[1] = nx; }
        const unsigned old = xb_add(&bar[XB_XSUB(b.x)], 1u);
        const unsigned gen = old / nloc;
        if (old + 1u == (gen + 1u) * nloc) {
            __builtin_amdgcn_fence(__ATOMIC_RELEASE, "agent");
            asm volatile("s_waitcnt vmcnt(0)" ::: "memory");
            const unsigned og = xb_add(&bar[XB_TOP], 1u);
            const unsigned tg = og / nx;
            if (og + 1u == (tg + 1u) * nx) xb_add(&bar[XB_TOPGEN], 1u);
            else XB_SPIN(xb_ld(&bar[XB_TOPGEN]) == tg, bar);
            __builtin_amdgcn_fence(__ATOMIC_ACQUIRE, "agent");
            xb_add(&bar[XB_XGEN(b.x)], 1u);
            asm volatile("s_waitcnt vmcnt(0)" ::: "memory");
        } else {
            XB_SPIN(xb_ld(&bar[XB_XGEN(b.x)]) == gen, bar);
            __builtin_amdgcn_fence(__ATOMIC_ACQUIRE, "agent");
            asm volatile("s_waitcnt vmcnt(0)" ::: "memory");
        }
    }
    __syncthreads();
}

constexpr int NWAVES = 8;
constexpr int BATCH = 8, SEQ = 2048, D = 1024, M = BATCH * SEQ, FF = 2816, NGU = 2 * FF, NINA = 5120, NING = 2048, NMOD = 9216;
constexpr float EPS = 1e-6f, LOG2E = 1.4426950408889634f, QSCALE = 0.125f * LOG2E;
#ifndef MK_N_LAUNCHES
#define MK_N_LAUNCHES 14
#endif
constexpr int N_PHASES = 14;
#ifndef SKIP_MASK
#define SKIP_MASK 0
#endif
constexpr int N_LAUNCHES = MK_N_LAUNCHES;

constexpr size_t MiB = 1u << 20;
constexpr size_t WS_CTL = 0, CTL_ZERO_BYTES = 64 * 1024;
constexpr size_t WS_MOD = 1 * MiB;
constexpr size_t WS_BIAST = WS_MOD + 512 * 1024;
constexpr size_t WS_PAR = WS_BIAST + 8192;
constexpr size_t WS_WSP = WS_MOD + 768 * 1024;
constexpr size_t WS_GVSTAT = 2 * MiB;
constexpr size_t WS_WGU1 = 3 * MiB, WS_WD1 = WS_WGU1 + (size_t)NGU * D * 2, WS_WINA = WS_WD1 + (size_t)D * FF * 2, WS_WING = WS_WINA + (size_t)NINA * D * 2;
constexpr size_t WS_WA = WS_WING + (size_t)NING * D * 2, WS_WB = WS_WA + (size_t)D * D * 2, WS_WO = WS_WB + (size_t)D * D * 2;
constexpr size_t WS_WGU2 = WS_WO + (size_t)D * D * 2, WS_WD2 = WS_WGU2 + (size_t)NGU * D * 2, WS_WEND = WS_WD2 + (size_t)D * FF * 2;
constexpr size_t WS_XN = 56 * MiB;
constexpr size_t WS_ACT = 88 * MiB;
constexpr size_t ACT1 = (size_t)M * D * 2;
constexpr size_t WS_END = WS_ACT + 5 * ACT1;
static_assert(WS_WEND <= WS_XN && WS_XN + ACT1 <= WS_ACT && WS_END <= 256 * MiB && (size_t)M * FF * 2 <= 3 * ACT1, "d_ws map");
constexpr int CW_BAR = 1024;

constexpr int RING_OFF = 0, RING_BYTES = 131072;
constexpr int LDSCTL_OFF = RING_BYTES, MISC_OFF = LDSCTL_OFF + 320;
constexpr int LDS_BYTES = 147456;
constexpr int L_K = 0, L_V = 16384, L_BIAS = 32768, L_WSF = 33792, L_QF = 40960;

typedef float f32x16 __attribute__((ext_vector_type(16)));
typedef short s16x4 __attribute__((ext_vector_type(4)));
typedef unsigned v2u __attribute__((ext_vector_type(2)));
typedef short v4i16_t __attribute__((ext_vector_type(4)));

struct Args { const float* in[26]; float* out; unsigned char* ws; int ph_lo, ph_hi, li, pad; };
struct Frame {
    LAS unsigned char* lds;
    volatile LAS unsigned* MISC;
    gu32* ctl;
    int tid, lane, wave, vcu, G;
    const Args* a;
    unsigned char* ws;
    float* out;
};
#define IN_PTR(name, k) __device__ __forceinline__ const float* name(const Frame& F) { return F.a->in[k]; }
IN_PTR(p_x, 0) IN_PTR(p_c, 1) IN_PTR(p_w_ada, 2) IN_PTR(p_b_ada, 3) IN_PTR(p_w1g, 4) IN_PTR(p_w1u, 5) IN_PTR(p_w1d, 6) IN_PTR(p_w_in, 7) IN_PTR(p_q_g, 8) IN_PTR(p_k_g, 9)
IN_PTR(p_lq1, 10) IN_PTR(p_lk1, 11) IN_PTR(p_lq2, 12) IN_PTR(p_lk2, 13) IN_PTR(p_sub_g, 14) IN_PTR(p_relb, 15) IN_PTR(p_ln_g, 16) IN_PTR(p_ln_b, 17) IN_PTR(p_w_sp, 18) IN_PTR(p_b_sp, 19)
IN_PTR(p_w_a, 20) IN_PTR(p_w_b, 21) IN_PTR(p_w_o, 22) IN_PTR(p_w2g, 23) IN_PTR(p_w2u, 24) IN_PTR(p_w2d, 25)
#define WS_F32(name, off) __device__ __forceinline__ float* name(const Frame& F) { return (float*)(F.ws + (off)); }
#define WS_B16(name, off) __device__ __forceinline__ bf16* name(const Frame& F) { return (bf16*)(F.ws + (off)); }
WS_F32(p_MOD, WS_MOD) WS_F32(p_BIAST, WS_BIAST) WS_F32(p_PAR, WS_PAR) WS_F32(p_GVSTAT, WS_GVSTAT)
WS_B16(p_WSP, WS_WSP) WS_B16(p_WGU1, WS_WGU1) WS_B16(p_WD1, WS_WD1) WS_B16(p_WINA, WS_WINA) WS_B16(p_WING, WS_WING) WS_B16(p_WA, WS_WA) WS_B16(p_WB, WS_WB) WS_B16(p_WO, WS_WO) WS_B16(p_WGU2, WS_WGU2) WS_B16(p_WD2, WS_WD2)
WS_B16(p_XN, WS_XN) WS_B16(p_Q, WS_ACT) WS_B16(p_K, WS_ACT + ACT1) WS_B16(p_V, WS_ACT + 2 * ACT1) WS_B16(p_U, WS_ACT + 3 * ACT1) WS_B16(p_GV, WS_ACT + 4 * ACT1) WS_B16(p_H, WS_ACT)


__device__ __forceinline__ float wave_sum(float v) {
#pragma unroll
    for (int o = 1; o < 64; o <<= 1) v += __shfl_xor(v, o);
    return v;
}
__device__ __forceinline__ float wave_max(float v) {
#pragma unroll
    for (int o = 1; o < 64; o <<= 1) v = fmaxf(v, __shfl_xor(v, o));
    return v;
}
__device__ __forceinline__ float bflo(unsigned w) { return __uint_as_float(w << 16); }
__device__ __forceinline__ float bfhi(unsigned w) { return __uint_as_float(w & 0xffff0000u); }

__device__ __forceinline__ void p0_transpose_item(const float* W, int ldw, int K, bf16* WT, int rowbase, int k0, int n0, LAS float* scr, int lane) {
#pragma unroll 8
    for (int i = 0; i < 32; ++i) { const int kk = 2 * i + (lane >> 5); scr[kk * 33 + (lane & 31)] = W[(size_t)(k0 + kk) * ldw + n0 + (lane & 31)]; }
    LDS_WAIT(); asm volatile("" ::: "memory");
    const int c = lane & 7;
#pragma unroll
    for (int j = 0; j < 4; ++j) { const int n = (lane >> 3) + 8 * j; const LAS float* s = scr + (8 * c) * 33 + n;
        v4u o; o.x = pk2(s[0 * 33], s[1 * 33]); o.y = pk2(s[2 * 33], s[3 * 33]); o.z = pk2(s[4 * 33], s[5 * 33]); o.w = pk2(s[6 * 33], s[7 * 33]);
        *(GAS v4u*)(WT + (size_t)(rowbase + n) * K + k0 + 8 * c) = o; }
    LDS_WAIT(); asm volatile("" ::: "memory");
}
__device__ __forceinline__ void p0_tr_plain(const float* W, int K, int N, bf16* WT, int item, LAS float* scr, int lane) {
    const int nblk = N / 32, kb = item / nblk, nb = item % nblk;
    p0_transpose_item(W, N, K, WT, 32 * nb, 64 * kb, 32 * nb, scr, lane);
}
__device__ __forceinline__ void p0_tr_gu(const float* W, bf16* WT, int up, int item, LAS float* scr, int lane) {
    const int nblk = FF / 32, kb = item / nblk, nb = item % nblk, n0 = 32 * nb;
    p0_transpose_item(W, FF, D, WT, 256 * (n0 >> 7) + 128 * up + (n0 & 127), 64 * kb, n0, scr, lane);
}
__device__ __forceinline__ void p0_tr_in(Frame& F, int item, LAS float* scr, int lane) {
    const int nblk = 7168 / 32, kb = item / nblk, nb = item % nblk, n0 = 32 * nb;
    bf16* WT = p_WINA(F); int rb = n0;
    if (n0 < 2048) rb = (n0 & ~255) + 128 * ((n0 & 63) >> 5) + 32 * ((n0 & 255) >> 6);
    else if (n0 >= NINA) { WT = p_WING(F); rb = n0 - NINA; }
    p0_transpose_item(p_w_in(F), 7168, D, WT, rb, 64 * kb, n0, scr, lane);
}
__device__ __forceinline__ void p0_prologue(Frame& F) {
    {
        LAS float* sl = (LAS float*)(F.lds);
        LAS float* red = sl + 8192;
        for (int i = F.tid; i < 8192; i += NWAVES * 64) { const float v = p_c(F)[i]; sl[i] = v / (1.0f + __expf(-v)); }
        __syncthreads();
        const int cl = F.tid % 36, kl = F.tid / 36;
        for (int item = F.vcu; item < 256; item += F.G) {
            const int n0 = item * 36;
            if (kl < 14) {
                float a0 = 0.f, a1 = 0.f, a2 = 0.f, a3 = 0.f, a4 = 0.f, a5 = 0.f, a6 = 0.f, a7 = 0.f;
                for (int k = kl; k < 1024; k += 14) { const float w = p_w_ada(F)[(size_t)k * NMOD + n0 + cl];
                    a0 += sl[k] * w; a1 += sl[1024 + k] * w; a2 += sl[2048 + k] * w; a3 += sl[3072 + k] * w; a4 += sl[4096 + k] * w; a5 += sl[5120 + k] * w; a6 += sl[6144 + k] * w; a7 += sl[7168 + k] * w; }
                LAS float* r = red + kl * 288 + cl;
                r[0] = a0; r[36] = a1; r[72] = a2; r[108] = a3; r[144] = a4; r[180] = a5; r[216] = a6; r[252] = a7;
            }
            __syncthreads();
            if (F.tid < 288) { float s = p_b_ada(F)[n0 + (F.tid % 36)];
#pragma unroll
                for (int q = 0; q < 14; ++q) s += red[q * 288 + F.tid];
                p_MOD(F)[(size_t)(F.tid / 36) * NMOD + n0 + (F.tid % 36)] = s; }
            __syncthreads();
        }
    }
    if (F.vcu == 0) {
        if (F.wave == 0) {
            const float a = wave_sum(p_lq1(F)[F.lane] * p_lk1(F)[F.lane]), b = wave_sum(p_lq2(F)[F.lane] * p_lk2(F)[F.lane]);
            if (F.lane == 0) p_PAR(F)[0] = __expf(a) - __expf(b) + 0.2f;
        } else {
            const float gq = wave_max(fabsf(p_q_g(F)[F.lane])), gk = wave_max(fabsf(p_k_g(F)[F.lane]));
            for (int h = F.wave - 1; h < 8; h += 7) {
                const float tb = wave_max(F.lane < 32 ? fabsf(p_relb(F)[F.lane * 8 + h]) : 0.f);
                const float bound = (1.02f * 8.0f * gq * gk + tb) * LOG2E;
                for (int n = F.lane; n <= 128; n += 64) {
                    int bk = n;
                    if (n >= 16) { bk = 16 + (int)(logf((float)n / 16.0f) / logf(8.0f) * 16.0f); bk = bk > 31 ? 31 : bk; }
                    p_BIAST(F)[h * 160 + n] = p_relb(F)[bk * 8 + h] * LOG2E - bound;
                }
            }
        }
    }
    for (int i = F.vcu * (NWAVES * 64) + F.tid; i < 8 * 128 * 128; i += F.G * NWAVES * 64) {
        const int s = i & 127, t = (i >> 7) & 127; p_WSP(F)[i] = (s <= t) ? (bf16)f2bf(p_w_sp(F)[i]) : (bf16)0; }
    LAS float* scr = (LAS float*)(F.lds + RING_OFF + F.wave * 16384);
    __syncthreads();
    const int gw = F.vcu * NWAVES + F.wave, NGW = F.G * NWAVES;
    constexpr int I_GU = (D / 64) * (FF / 32), I_D = (FF / 64) * (D / 32), I_IN = (D / 64) * (7168 / 32), I_P = (D / 64) * (D / 32);
    constexpr int NITEMS = 4 * I_GU + 2 * I_D + I_IN + 3 * I_P;
    for (int it = gw; it < NITEMS; it += NGW) {
        int r = it;
        if (r < I_GU) { p0_tr_gu(p_w1g(F), p_WGU1(F), 0, r, scr, F.lane); continue; } r -= I_GU;
        if (r < I_GU) { p0_tr_gu(p_w1u(F), p_WGU1(F), 1, r, scr, F.lane); continue; } r -= I_GU;
        if (r < I_D) { p0_tr_plain(p_w1d(F), FF, D, p_WD1(F), r, scr, F.lane); continue; } r -= I_D;
        if (r < I_IN) { p0_tr_in(F, r, scr, F.lane); continue; } r -= I_IN;
        if (r < I_P) { p0_tr_plain(p_w_a(F), D, D, p_WA(F), r, scr, F.lane); continue; } r -= I_P;
        if (r < I_P) { p0_tr_plain(p_w_b(F), D, D, p_WB(F), r, scr, F.lane); continue; } r -= I_P;
        if (r < I_P) { p0_tr_plain(p_w_o(F), D, D, p_WO(F), r, scr, F.lane); continue; } r -= I_P;
        if (r < I_GU) { p0_tr_gu(p_w2g(F), p_WGU2(F), 0, r, scr, F.lane); continue; } r -= I_GU;
        if (r < I_GU) { p0_tr_gu(p_w2u(F), p_WGU2(F), 1, r, scr, F.lane); continue; } r -= I_GU;
        p0_tr_plain(p_w2d(F), FF, D, p_WD2(F), r, scr, F.lane);
    }
}

__device__ __forceinline__ void norm_rows(Frame& F, const float* src, int sub) {
    const int gw = F.vcu * NWAVES + F.wave, NGW = F.G * NWAVES;
    for (int m = gw; m < M; m += NGW) {
        const float* sh = p_MOD(F) + (size_t)(m >> 11) * NMOD + (3 * sub) * 1024; const float* sc = sh + 1024;
        const GAS f32x4* xr = (const GAS f32x4*)(src + (size_t)m * D) + F.lane;
        f32x4 v[4]; float s = 0.f;
#pragma unroll
        for (int j = 0; j < 4; ++j) { v[j] = xr[64 * j]; s += (v[j].x * v[j].x + v[j].y * v[j].y) + (v[j].z * v[j].z + v[j].w * v[j].w); }
        const float rstd = 1.0f / sqrtf(wave_sum(s) * (1.f / D) + EPS);
        GAS unsigned long long* o8 = (GAS unsigned long long*)(p_XN(F) + (size_t)m * D) + F.lane;
#pragma unroll
        for (int j = 0; j < 4; ++j) { const f32x4 a = *((const GAS f32x4*)sc + F.lane + 64 * j), b = *((const GAS f32x4*)sh + F.lane + 64 * j);
            const f32x4 o = v[j] * rstd * (a + 1.0f) + b;
            o8[64 * j] = (unsigned long long)pk2(o.x, o.y) | ((unsigned long long)pk2(o.z, o.w) << 32); }
    }
}
__device__ __forceinline__ void qknorm_rows(Frame& F) {
    const int gw = F.vcu * NWAVES + F.wave, NGW = F.G * NWAVES, lane = F.lane;
    float gq[16], gk[16];
#pragma unroll
    for (int e = 0; e < 16; ++e) { gq[e] = p_q_g(F)[(lane & 3) * 16 + e] * QSCALE; gk[e] = p_k_g(F)[(lane & 3) * 16 + e]; }
    for (int m = gw; m < M; m += NGW) {
#pragma unroll
        for (int w = 0; w < 2; ++w) {
            bf16* p = (w ? p_K(F) : p_Q(F)) + (size_t)m * D + lane * 16;
            const v4u a = *(const GAS v4u*)p, b = *(const GAS v4u*)(p + 8);
            float x[16] = {bflo(a.x), bfhi(a.x), bflo(a.y), bfhi(a.y), bflo(a.z), bfhi(a.z), bflo(a.w), bfhi(a.w), bflo(b.x), bfhi(b.x), bflo(b.y), bfhi(b.y), bflo(b.z), bfhi(b.z), bflo(b.w), bfhi(b.w)};
            float s = 0.f;
#pragma unroll
            for (int e = 0; e < 16; ++e) s += x[e] * x[e];
            s += __shfl_xor(s, 1); s += __shfl_xor(s, 2);
            const float rstd = 1.0f / sqrtf(s * (1.f / 64.f) + EPS);
#pragma unroll
            for (int e = 0; e < 16; ++e) x[e] = x[e] * rstd * (w ? gk[e] : gq[e]);
            v4u oa, ob; oa.x = pk2(x[0], x[1]); oa.y = pk2(x[2], x[3]); oa.z = pk2(x[4], x[5]); oa.w = pk2(x[6], x[7]); ob.x = pk2(x[8], x[9]); ob.y = pk2(x[10], x[11]); ob.z = pk2(x[12], x[13]); ob.w = pk2(x[14], x[15]);
            *(GAS v4u*)p = oa; *(GAS v4u*)(p + 8) = ob;
        }
        {
            const bf16* p = p_GV(F) + (size_t)m * D + lane * 16;
            const v4u a = *(const GAS v4u*)p, b = *(const GAS v4u*)(p + 8);
            const float x[16] = {bflo(a.x), bfhi(a.x), bflo(a.y), bfhi(a.y), bflo(a.z), bfhi(a.z), bflo(a.w), bfhi(a.w), bflo(b.x), bfhi(b.x), bflo(b.y), bfhi(b.y), bflo(b.z), bfhi(b.z), bflo(b.w), bfhi(b.w)};
            float s = 0.f;
#pragma unroll
            for (int e = 0; e < 16; ++e) s += x[e];
            const float mean = wave_sum(s) * (1.f / D); float q = 0.f;
#pragma unroll
            for (int e = 0; e < 16; ++e) { const float d = x[e] - mean; q += d * d; }
            const float rstd = 1.0f / sqrtf(wave_sum(q) * (1.f / D) + EPS);
            if (lane == 0) { p_GVSTAT(F)[2 * (size_t)m] = mean; p_GVSTAT(F)[2 * (size_t)m + 1] = rstd; }
        }
    }
}

__device__ __forceinline__ int crow(int r, int hi) { return (r & 3) + 8 * (r >> 2) + 4 * hi; }
__device__ __forceinline__ s16x4 vtr(const LAS unsigned char* p) { return __builtin_bit_cast(s16x4, __builtin_amdgcn_ds_read_tr16_b64_v4i16((LAS v4i16_t*)p)); }
__device__ __forceinline__ bf16x8 pack8f(const f32x16& p, int b) {
    v4u w; w.x = pg8::cvt_pk_bf16(p[b], p[b + 1]); w.y = pg8::cvt_pk_bf16(p[b + 2], p[b + 3]); w.z = pg8::cvt_pk_bf16(p[b + 4], p[b + 5]); w.w = pg8::cvt_pk_bf16(p[b + 6], p[b + 7]);
    return __builtin_bit_cast(bf16x8, w);
}
__device__ __forceinline__ void attn_unit(Frame& F, int b, int h, int qb) {
    const int tid = F.tid, lane = F.lane, r32 = lane & 31, hi = lane >> 5, wid = F.wave, map = wid >> 2, wq = wid & 3;
    LAS unsigned char* lds = F.lds;
    LAS float* biasL = (LAS float*)(lds + L_BIAS);
    LAS float* wsf = (LAS float*)(lds + L_WSF) + wid * 64;
    const size_t rowbase = (size_t)b * SEQ; const int q0 = qb * 128;
    __syncthreads();
    if (tid < 129) biasL[tid] = p_BIAST(F)[h * 160 + tid];
    bf16x8 qr[4];
    { const bf16* Qw = p_Q(F) + (rowbase + q0 + wq * 32 + r32) * D + h * 128 + map * 64 + hi * 8;
#pragma unroll
      for (int d0 = 0; d0 < 4; ++d0) qr[d0] = __builtin_bit_cast(bf16x8, *(const GAS v4u*)(Qw + d0 * 16)); }
    f32x16 o[4];
#pragma unroll
    for (int i = 0; i < 4; ++i) o[i] = f32x16{};
    float l = 0.f;
    const int NT = 2 * (qb + 1), qpos = q0 + wq * 32 + r32;
    const bf16* Kg = p_K(F) + rowbase * D + h * 128; const bf16* Vg = p_V(F) + rowbase * D + h * 128;
    const int skv = tid >> 4, sch = tid & 15;
    const LAS unsigned char* vp = lds + L_V + ((lane >> 4) & 1) * 32 + (lane & 3) * 8 + (4 * hi + ((lane & 15) >> 2)) * 64;
    for (int t = 0; t < NT; ++t) {
        __syncthreads();
#pragma unroll
        for (int i = 0; i < 2; ++i) { const int kv = skv + 32 * i; const size_t go = (size_t)(64 * t + kv) * D + sch * 8;
            const v4u kk = *(const GAS v4u*)(Kg + go); const v4u vv = *(const GAS v4u*)(Vg + go);
            *(LAS v4u*)(lds + L_K + kv * 256 + ((sch ^ (kv & 15)) << 4)) = kk;
            *(LAS v4u*)(lds + L_V + (sch >> 2) * 4096 + (kv >> 4) * 1024 + (kv & 15) * 64 + (sch & 3) * 16) = vv; }
        __syncthreads();
        f32x16 p0 = f32x16{}, p1 = f32x16{};
#pragma unroll
        for (int d0 = 0; d0 < 4; ++d0) { const int ch = map * 8 + 2 * d0 + hi, sw = (ch ^ (r32 & 15)) << 4;
            const bf16x8 k0 = *(const LAS bf16x8*)(lds + L_K + r32 * 256 + sw), k1 = *(const LAS bf16x8*)(lds + L_K + (r32 + 32) * 256 + sw);
            p0 = __builtin_amdgcn_mfma_f32_32x32x16_bf16(k0, qr[d0], p0, 0, 0, 0); p1 = __builtin_amdgcn_mfma_f32_32x32x16_bf16(k1, qr[d0], p1, 0, 0, 0); }
        float s = 0.f;
#pragma unroll
        for (int r = 0; r < 16; ++r) { const int n0 = qpos - (64 * t + crow(r, hi)), n1 = n0 - 32;
            const float b0 = biasL[min(max(n0, 0), 128)], b1 = biasL[min(max(n1, 0), 128)];
            float e0 = __builtin_amdgcn_exp2f(p0[r] + b0), e1 = __builtin_amdgcn_exp2f(p1[r] + b1);
            e0 = n0 >= 0 ? e0 : 0.f; e1 = n1 >= 0 ? e1 : 0.f;
            p0[r] = e0; p1[r] = e1; s += e0 + e1; }
        l += s;
        const bf16x8 pw0 = pack8f(p0, 0), pw1 = pack8f(p0, 8), pw2 = pack8f(p1, 0), pw3 = pack8f(p1, 8);
#pragma unroll
        for (int d0 = 0; d0 < 4; ++d0) {
#define VF(ks) ({ const s16x4 lo_ = vtr(vp + d0 * 4096 + (ks) * 1024), hh_ = vtr(vp + d0 * 4096 + (ks) * 1024 + 512); (bf16x8){lo_[0], lo_[1], lo_[2], lo_[3], hh_[0], hh_[1], hh_[2], hh_[3]}; })
            o[d0] = __builtin_amdgcn_mfma_f32_32x32x16_bf16(pw0, VF(0), o[d0], 0, 0, 0);
            o[d0] = __builtin_amdgcn_mfma_f32_32x32x16_bf16(pw1, VF(1), o[d0], 0, 0, 0);
            o[d0] = __builtin_amdgcn_mfma_f32_32x32x16_bf16(pw2, VF(2), o[d0], 0, 0, 0);
            o[d0] = __builtin_amdgcn_mfma_f32_32x32x16_bf16(pw3, VF(3), o[d0], 0, 0, 0);
#undef VF
        }
    }
    l += __shfl_xor(l, 32);
    const float lam = p_PAR(F)[0];
    if (hi == 0) wsf[r32] = map ? lam / l : 1.0f / l;
    LDS_WAIT();
    LAS float* xch = (LAS float*)(lds + L_QF) + wq * 4096;
    if (map) {
#pragma unroll
        for (int r = 0; r < 16; ++r) { const float i2 = wsf[crow(r, hi)];
#pragma unroll
            for (int d0 = 0; d0 < 4; ++d0) xch[(d0 * 16 + r) * 64 + lane] = o[d0][r] * i2; }
    }
    __syncthreads();
    if (!map) {
        float gs[4];
#pragma unroll
        for (int d0 = 0; d0 < 4; ++d0) gs[d0] = p_sub_g(F)[32 * d0 + r32] * 0.8f;
        f32x16 a[4];
#pragma unroll
        for (int r = 0; r < 16; ++r) { const float i1 = wsf[crow(r, hi)]; float ss = 0.f;
#pragma unroll
            for (int d0 = 0; d0 < 4; ++d0) { const float v = o[d0][r] * i1 - xch[(d0 * 16 + r) * 64 + lane]; a[d0][r] = v; ss += v * v; }
            ss += __shfl_xor(ss, 1); ss += __shfl_xor(ss, 2); ss += __shfl_xor(ss, 4); ss += __shfl_xor(ss, 8); ss += __shfl_xor(ss, 16);
            const float rstd = 1.0f / sqrtf(ss * (1.f / 128.f) + EPS);
#pragma unroll
            for (int d0 = 0; d0 < 4; ++d0) a[d0][r] *= rstd * gs[d0]; }
        LAS bf16* stg = (LAS bf16*)xch;
        LDS_WAIT();
#pragma unroll
        for (int r = 0; r < 16; ++r)
#pragma unroll
            for (int d0 = 0; d0 < 4; ++d0) stg[crow(r, hi) * 128 + 32 * d0 + r32] = (bf16)f2bf(a[d0][r]);
        LDS_WAIT();
        bf16* Ow = p_Q(F) + (rowbase + q0 + wq * 32) * D + h * 128;
#pragma unroll
        for (int i = 0; i < 8; ++i) { const int row = i * 4 + (lane >> 4), ch = lane & 15; *(GAS v4u*)(Ow + (size_t)row * D + ch * 8) = *(const LAS v4u*)(stg + row * 128 + ch * 8); }
    }
}
__device__ __forceinline__ void gmlp_unit(Frame& F, int b, int nc, int g) {
    const int tid = F.tid, lane = F.lane, r32 = lane & 31, hi = lane >> 5, wid = F.wave;
    LAS unsigned char* lds = F.lds;
    const size_t t0 = (size_t)b * SEQ + 128 * nc; const int c0 = 128 * g;
    __syncthreads();
    { const int s_ = tid >> 4, ch = tid & 15;
      float lg[8], lb[8];
#pragma unroll
      for (int e = 0; e < 8; ++e) { lg[e] = p_ln_g(F)[c0 + ch * 8 + e]; lb[e] = p_ln_b(F)[c0 + ch * 8 + e]; }
#pragma unroll
      for (int i = 0; i < 4; ++i) { const int s = s_ + 32 * i; const v4u raw = *(const GAS v4u*)(p_GV(F) + (t0 + s) * D + c0 + ch * 8);
          const float mean = p_GVSTAT(F)[2 * (t0 + s)], rstd = p_GVSTAT(F)[2 * (t0 + s) + 1];
          const float x[8] = {bflo(raw.x), bfhi(raw.x), bflo(raw.y), bfhi(raw.y), bflo(raw.z), bfhi(raw.z), bflo(raw.w), bfhi(raw.w)};
          float y[8];
#pragma unroll
          for (int e = 0; e < 8; ++e) y[e] = (x[e] - mean) * rstd * lg[e] + lb[e];
          v4u o; o.x = pk2(y[0], y[1]); o.y = pk2(y[2], y[3]); o.z = pk2(y[4], y[5]); o.w = pk2(y[6], y[7]);
          *(LAS v4u*)(lds + (s >> 6) * 16384 + (ch >> 2) * 4096 + ((s & 63) >> 4) * 1024 + (s & 15) * 64 + (ch & 3) * 16) = o; } }
    __syncthreads();
    const int tb = wid >> 1, cbb = 2 * (wid & 1);
    f32x16 acc0 = f32x16{}, acc1 = f32x16{};
    const bf16* Wr = p_WSP(F) + ((size_t)g * 128 + 32 * tb + r32) * 128 + 4 * hi;
    const LAS unsigned char* vp = lds + ((lane >> 4) & 1) * 32 + (lane & 3) * 8 + (4 * hi + ((lane & 15) >> 2)) * 64;
    for (int ks = 0; ks < 2 * (tb + 1); ++ks) {
        const v2u alo = *(const GAS v2u*)(Wr + 16 * ks), ahi = *(const GAS v2u*)(Wr + 16 * ks + 8);
        const bf16x8 af = __builtin_bit_cast(bf16x8, (v4u){alo.x, alo.y, ahi.x, ahi.y});
        const LAS unsigned char* vt = vp + (ks >> 2) * 16384 + (ks & 3) * 1024 + cbb * 4096;
        const s16x4 l0 = vtr(vt), h0 = vtr(vt + 512), l1 = vtr(vt + 4096), h1 = vtr(vt + 4096 + 512);
        acc0 = __builtin_amdgcn_mfma_f32_32x32x16_bf16(af, (bf16x8){l0[0], l0[1], l0[2], l0[3], h0[0], h0[1], h0[2], h0[3]}, acc0, 0, 0, 0);
        acc1 = __builtin_amdgcn_mfma_f32_32x32x16_bf16(af, (bf16x8){l1[0], l1[1], l1[2], l1[3], h1[0], h1[1], h1[2], h1[3]}, acc1, 0, 0, 0);
    }
#pragma unroll
    for (int r = 0; r < 16; ++r) { const int t = 32 * tb + crow(r, hi); const float bs = p_b_sp(F)[g * 128 + t];
        bf16* up = p_U(F) + (t0 + t) * D + c0 + 32 * cbb + r32;
        const float u0 = __uint_as_float((unsigned)up[0] << 16), u1 = __uint_as_float((unsigned)up[32] << 16);
        up[0] = (bf16)f2bf((acc0[r] + bs) * u0); up[32] = (bf16)f2bf((acc1[r] + bs) * u1); }
}

__global__ void __launch_bounds__(NWAVES * 64, 2) mk_fwd(Args args) {
    extern __shared__ __attribute__((aligned(16))) unsigned char lds[];
    Frame F;
    F.lds = (LAS unsigned char*)lds;
    F.MISC = (volatile LAS unsigned*)(F.lds + MISC_OFF);
    F.tid = threadIdx.x; F.lane = F.tid & 63; F.wave = __builtin_amdgcn_readfirstlane(F.tid >> 6);
    F.G = gridDim.x; { const int bx = blockIdx.x; F.vcu = (F.G % 8 == 0) ? (bx % 8) * (F.G / 8) + bx / 8 : bx; }
    unsigned char* ws = args.ws;
    F.ctl = (gu32*)(ws + WS_CTL);
    F.a = &args; F.ws = ws; F.out = args.out;
    for (int u = F.tid; u < (LDS_BYTES - LDSCTL_OFF) / 4; u += NWAVES * 64) ((LAS unsigned*)(F.lds + LDSCTL_OFF))[u] = 0u;
    __syncthreads();
    XcdBarrier bar; bar.bar = (unsigned*)(F.ctl + CW_BAR); bar.x = 0; bar.st = nullptr;
    if (N_LAUNCHES == 1) bar = xcd_barrier_post((unsigned*)(F.ctl + CW_BAR), F.MISC + 8);
#define GRID_BAR() do { if (N_LAUNCHES == 1) xcd_barrier(bar); } while (0)
    const int lo = args.ph_lo, hi = args.ph_hi;
#ifndef PH_MASK
#define PH_MASK 0xFFFF
#endif
#define IN(k) (((PH_MASK >> (k)) & 1) && lo <= (k) && (k) < hi)
#define BOTH(k) (IN(k) && IN((k) + 1))
    typedef pg8::StaticOrder SO;
    if (IN(0)) { p0_prologue(F); if (BOTH(0)) GRID_BAR(); }
    if (IN(1)) { norm_rows(F, p_x(F), 0); if (BOTH(1)) GRID_BAR(); }
    if (IN(2)) { pg8::Gemm g{p_XN(F), p_WGU1(F), M, NGU, D}; SO S; S.init(M, NGU, F.G, (int)blockIdx.x); pg8::EpiSwiGLU E{p_H(F), FF};
        pg8::gemm_phase<pg8::EpiSwiGLU, SO, PG8_ALIGN, PG8_SP2>(F.lds + RING_OFF, g, S, E); if (BOTH(2)) GRID_BAR(); }
    if (IN(3)) { pg8::Gemm g{p_H(F), p_WD1(F), M, D, FF}; SO S; S.init(M, D, F.G, (int)blockIdx.x); pg8::EpiResGate E{p_x(F), F.out, p_MOD(F), 2, (SKIP_MASK & 1) ? 0.f : 0.5f};
        pg8::gemm_phase<pg8::EpiResGate, SO, PG8_ALIGN, PG8_SP2>(F.lds + RING_OFF, g, S, E); if (BOTH(3)) GRID_BAR(); }
    if (IN(4)) { norm_rows(F, F.out, 1); if (BOTH(4)) GRID_BAR(); }
    if (IN(5)) { pg8::Gemm g{p_XN(F), p_WINA(F), M, NINA, D}; SO S; S.init(M, NINA, F.G, (int)blockIdx.x); pg8::EpiInA E{p_Q(F), p_K(F), p_V(F), p_U(F), p_GV(F)};
        pg8::gemm_phase<pg8::EpiInA, SO, PG8_ALIGN, PG8_SP2>(F.lds + RING_OFF, g, S, E); if (BOTH(5)) GRID_BAR(); }
    if (IN(6)) { qknorm_rows(F); if (BOTH(6)) GRID_BAR(); }
    if (IN(7)) {
        for (int p = F.vcu; p < 256; p += F.G) { const int bh = p >> 2, s = p & 3; attn_unit(F, bh >> 3, bh & 7, s); attn_unit(F, bh >> 3, bh & 7, 7 - s); attn_unit(F, bh >> 3, bh & 7, 8 + s); attn_unit(F, bh >> 3, bh & 7, 15 - s); }
        for (int i = F.vcu; i < 1024; i += F.G) gmlp_unit(F, i >> 7, (i >> 3) & 15, i & 7);
        __syncthreads();
        if (BOTH(7)) GRID_BAR(); }
    if (IN(8)) { pg8::Gemm g{p_XN(F), p_WING(F), M, NING, D}; SO S; S.init(M, NING, F.G, (int)blockIdx.x); pg8::EpiGate E{p_K(F), p_V(F)};
        pg8::gemm_phase<pg8::EpiGate, SO, PG8_ALIGN, PG8_SP2>(F.lds + RING_OFF, g, S, E); if (BOTH(8)) GRID_BAR(); }
    if (IN(9)) { SO S; S.init(M, D, F.G, (int)blockIdx.x);
        { pg8::Gemm g{p_Q(F), p_WA(F), M, D, D}; pg8::EpiProj<false> E{p_K(F), p_GV(F), (SKIP_MASK & 8) ? 0.f : 1.f}; pg8::gemm_phase<pg8::EpiProj<false>, SO, PG8_ALIGN, PG8_SP2>(F.lds + RING_OFF, g, S, E); }
        { pg8::Gemm g{p_U(F), p_WB(F), M, D, D}; pg8::EpiProj<true> E{p_V(F), p_GV(F), (SKIP_MASK & 16) ? 0.f : 1.f}; pg8::gemm_phase<pg8::EpiProj<true>, SO, PG8_ALIGN, PG8_SP2>(F.lds + RING_OFF, g, S, E); }
        if (BOTH(9)) GRID_BAR(); }
    if (IN(10)) { pg8::Gemm g{p_GV(F), p_WO(F), M, D, D}; SO S; S.init(M, D, F.G, (int)blockIdx.x); pg8::EpiResGate E{F.out, F.out, p_MOD(F), 5, (SKIP_MASK & 2) ? 0.f : 1.0f};
        pg8::gemm_phase<pg8::EpiResGate, SO, PG8_ALIGN, PG8_SP2>(F.lds + RING_OFF, g, S, E); if (BOTH(10)) GRID_BAR(); }
    if (IN(11)) { norm_rows(F, F.out, 2); if (BOTH(11)) GRID_BAR(); }
    if (IN(12)) { pg8::Gemm g{p_XN(F), p_WGU2(F), M, NGU, D}; SO S; S.init(M, NGU, F.G, (int)blockIdx.x); pg8::EpiSwiGLU E{p_H(F), FF};
        pg8::gemm_phase<pg8::EpiSwiGLU, SO, PG8_ALIGN, PG8_SP2>(F.lds + RING_OFF, g, S, E); if (BOTH(12)) GRID_BAR(); }
    if (IN(13)) { pg8::Gemm g{p_H(F), p_WD2(F), M, D, FF}; SO S; S.init(M, D, F.G, (int)blockIdx.x); pg8::EpiResGate E{F.out, F.out, p_MOD(F), 8, (SKIP_MASK & 4) ? 0.f : 0.5f};
        pg8::gemm_phase<pg8::EpiResGate, SO, PG8_ALIGN, PG8_SP2>(F.lds + RING_OFF, g, S, E); }
#undef IN
#undef BOTH
}

extern "C" void kernel_launch(void* const* d_in, const int* in_sizes, int n_in, void* d_out, int out_size, void* d_ws, size_t ws_size, hipStream_t stream) {
    static int grid = 0;
    if (grid == 0) {
        if (n_in != 26 || in_sizes[0] != M * D || out_size != M * D || ws_size < WS_END) { fprintf(stderr, "kernel_launch: unexpected problem (n_in %d, in0 %d, out %d, ws %zu)\n", n_in, n_in > 0 ? in_sizes[0] : -1, out_size, ws_size); grid = -1; return; }
        int dev = 0, cus = 0;
        if (hipGetDevice(&dev) != hipSuccess || hipDeviceGetAttribute(&cus, hipDeviceAttributeMultiprocessorCount, dev) != hipSuccess) { grid = -1; return; }
        if (hipFuncSetAttribute((const void*)mk_fwd, hipFuncAttributeMaxDynamicSharedMemorySize, LDS_BYTES) != hipSuccess) { fprintf(stderr, "kernel_launch: hipFuncSetAttribute failed\n"); grid = -1; return; }
        int per_cu = 0;
        if (hipOccupancyMaxActiveBlocksPerMultiprocessor(&per_cu, (const void*)mk_fwd, NWAVES * 64, LDS_BYTES) != hipSuccess || per_cu < 1) fprintf(stderr, "kernel_launch: occupancy query says %d\n", per_cu);
        (void)hipGetLastError();
        grid = cus;
    }
    if (grid < 0) return;
    if (hipMemsetAsync((char*)d_ws + WS_CTL, 0, CTL_ZERO_BYTES, stream) != hipSuccess) return;
    Args a{};
    for (int i = 0; i < 26; ++i) a.in[i] = (const float*)d_in[i];
    a.out = (float*)d_out; a.ws = (unsigned char*)d_ws;
    for (int li = 0; li < N_LAUNCHES; ++li) {
        a.ph_lo = (N_LAUNCHES == 1) ? 0 : li; a.ph_hi = (N_LAUNCHES == 1) ? N_PHASES : li + 1; a.li = li;
        hipLaunchKernelGGL(mk_fwd, dim3(grid), dim3(NWAVES * 64), LDS_BYTES, stream, a);
    }
}
```

```cpp
#define NR4 4
#define NR11 4
#include <hip/hip_runtime.h>
#include <cstdio>
#include <cstdint>
namespace pg8 {
#define PG8_LAS __attribute__((address_space(3)))
typedef unsigned short bf16_t;
typedef short bf16x8 __attribute__((ext_vector_type(8)));
typedef float f32x4 __attribute__((ext_vector_type(4)));
typedef unsigned u32x4 __attribute__((ext_vector_type(4)));
constexpr int BM = 256, BK = 64, HALF = 128, HTB = HALF * BK * 2  , STAGE_BYTES = 8 * HTB, NXCD = 8, WGM = 8;

__host__ __device__ __forceinline__ int lds_byte(int r, int c) { const int st = (r >> 4) * 2 + (c >> 5), rr = r & 15, cc = c & 31, ob = rr * 64 + cc * 2; return st * 1024 + (ob ^ (((ob >> 9) & 1) << 5)); }
__host__ __device__ __forceinline__ void stage_rc(int b, int& R, int& C) { const int st = b / 1024, sb = b % 1024, swz = sb ^ (((sb >> 9) & 1) << 5); R = (st >> 1) * 16 + swz / 64; C = (st & 1) * 32 + (swz % 64) / 2; }
__host__ __device__ __forceinline__ int perm32(int rho) { const int n = rho >> 4, i = rho & 15; return 8 * (i >> 2) + 4 * n + (i & 3); }

struct Unit { int pm, pn; };
struct Gemm { const bf16_t* A; const bf16_t* Bt; int M, N, K; };

struct StaticOrder {
    int nM, nN, nwg, G, c;
    __host__ __device__ void init(int M, int N, int G_, int c_) { nM = M / BM; nN = N / BM; nwg = nM * nN; G = G_; c = c_; }
    __host__ __device__ bool next(int i, Unit& u) const {
        const long L = (long)i * G + c; if (L >= nwg) return false;
        int wgid = (int)L; { const int q = nwg / NXCD, r = nwg % NXCD, xcd = wgid % NXCD, off = wgid / NXCD; wgid = (xcd < r ? xcd * (q + 1) : r * (q + 1) + (xcd - r) * q) + off; }
        const int nig = WGM * nN, gid = wgid / nig, fm = gid * WGM, gsz = (nM - fm) < WGM ? (nM - fm) : WGM;
        u.pm = fm + ((wgid % nig) % gsz); u.pn = (wgid % nig) / gsz; return true;
    }
    __device__ __forceinline__ void a_ready(const Unit&) const {}
    __device__ __forceinline__ void done(const Unit&) const {}
};

struct GateOrder {
    StaticOrder so;
    __host__ __device__ void init(int M, int N, int G_, int c_) { so.init(M, N, G_, c_); }
    __host__ __device__ bool next(int i, Unit& u) const { if (!so.next(i >> 1, u)) return false; u.pn += (i & 1) * so.nN; return true; }
    __device__ __forceinline__ void a_ready(const Unit&) const {}
    __device__ __forceinline__ void done(const Unit&) const {}
};

typedef float cvt_f32x2_t __attribute__((ext_vector_type(2))); typedef __bf16 cvt_bf16x2_t __attribute__((ext_vector_type(2)));
__device__ __forceinline__ unsigned cvt_pk_bf16(float lo, float hi) { cvt_f32x2_t v = {lo, hi}; cvt_bf16x2_t b = __builtin_convertvector(v, cvt_bf16x2_t); return __builtin_bit_cast(unsigned, b); }
typedef float f32x2 __attribute__((ext_vector_type(2)));
__device__ __forceinline__ f32x2 gelu_pk(f32x2 v) {
    const f32x2 av = __builtin_elementwise_abs(v), d = av * 0.2316418882f + 1.0f;
    f32x2 t; t.x = __builtin_amdgcn_rcpf(d.x); t.y = __builtin_amdgcn_rcpf(d.y);
    f32x2 q = t * 0.5307027145f + (-0.7265760135f); q = q * t + 0.7107068705f; q = q * t + (-0.142248368f); q = q * t + 0.127414796f; q = q * t;
    const f32x2 s = (v * v) * (-0.72134752044f);
    f32x2 e; e.x = __builtin_amdgcn_exp2f(s.x); e.y = __builtin_amdgcn_exp2f(s.y);
    const f32x2 m = v * (q * e), r = v - m;
    f32x2 o; o.x = v.x < 0.f ? m.x : r.x; o.y = v.y < 0.f ? m.y : r.y; return o;
}

__device__ __forceinline__ float bf2f(unsigned short h) { return __uint_as_float((unsigned)h << 16); }
__device__ __forceinline__ float bflo(unsigned w) { return __uint_as_float(w << 16); }
__device__ __forceinline__ float bfhi(unsigned w) { return __uint_as_float(w & 0xffff0000u); }
__device__ __forceinline__ float sigmoidf_fast(float x) { return __builtin_amdgcn_rcpf(1.0f + __builtin_amdgcn_exp2f(-1.4426950408889634f * x)); }
__device__ __forceinline__ u32x4 pack8(const f32x4& v0, const f32x4& v1) { u32x4 w; w.x = cvt_pk_bf16(v0[0], v0[1]); w.y = cvt_pk_bf16(v0[2], v0[3]); w.z = cvt_pk_bf16(v1[0], v1[1]); w.w = cvt_pk_bf16(v1[2], v1[3]); return w; }

struct EpiSwiGLU {
    static constexpr bool PERM = true, AFTER_DRAIN = false;
    bf16_t* H; int ldh;
    __device__ __forceinline__ void operator()(const f32x4 (&acc)[2][2][4][2], const Unit& u, int wr, int wc, int fr, int fq) const {
        const int row0 = u.pm * BM + wr * 64 + fr, col0 = u.pn * HALF + wc * 32 + 8 * fq;
#pragma unroll
        for (int ai = 0; ai < 2; ++ai)
#pragma unroll
            for (int m = 0; m < 4; ++m) { bf16_t* rowp = H + (size_t)(row0 + ai * HALF + m * 16) * ldh + col0;
                f32x4 h0, h1;
#pragma unroll
                for (int j = 0; j < 4; ++j) { const float g0 = acc[ai][0][m][0][j], g1 = acc[ai][0][m][1][j];
                    h0[j] = g0 * sigmoidf_fast(g0) * acc[ai][1][m][0][j]; h1[j] = g1 * sigmoidf_fast(g1) * acc[ai][1][m][1][j]; }
                *(u32x4*)rowp = pack8(h0, h1); }
    }
};
template <bool BASE_BF16, bool OUT_BF16, int gidx> struct EpiResGate {
    static constexpr bool PERM = true, AFTER_DRAIN = false;
    static constexpr float coef = gidx == 5 ? 1.0f : 0.5f;
    const void* base; void* out; const float* mod;
    __device__ __forceinline__ void ldb(f32x4& a, f32x4& b, size_t off) const {
        if (BASE_BF16) { const u32x4 w = *(const u32x4*)((const bf16_t*)base + off); a = (f32x4){bflo(w.x), bfhi(w.x), bflo(w.y), bfhi(w.y)}; b = (f32x4){bflo(w.z), bfhi(w.z), bflo(w.w), bfhi(w.w)}; }
        else { a = *(const f32x4*)((const float*)base + off); b = *(const f32x4*)((const float*)base + off + 4); }
    }
    __device__ __forceinline__ void operator()(const f32x4 (&acc)[2][2][4][2], const Unit& u, int wr, int wc, int fr, int fq) const {
        const int row0 = u.pm * BM + wr * 64 + fr, col0 = u.pn * BM + wc * 32 + 8 * fq;
        const float* gate = mod + (size_t)(u.pm >> 3) * 9216 + gidx * 1024 + col0;
        f32x4 gv[2][2];
#pragma unroll
        for (int bj = 0; bj < 2; ++bj)
#pragma unroll
            for (int n = 0; n < 2; ++n) gv[bj][n] = *(const f32x4*)(gate + bj * HALF + n * 4) * coef;
        f32x4 nb[2][2];
#pragma unroll
        for (int bj = 0; bj < 2; ++bj) ldb(nb[bj][0], nb[bj][1], (size_t)row0 * 1024 + col0 + bj * HALF);
#pragma unroll
        for (int g = 0; g < 8; ++g) { const int ai = g >> 2, m = g & 3; const size_t off = (size_t)(row0 + ai * HALF + m * 16) * 1024 + col0;
            f32x4 cb[2][2];
#pragma unroll
            for (int bj = 0; bj < 2; ++bj) { cb[bj][0] = nb[bj][0]; cb[bj][1] = nb[bj][1]; }
            if (g < 7) { const size_t off2 = (size_t)(row0 + ((g + 1) >> 2) * HALF + ((g + 1) & 3) * 16) * 1024 + col0;
#pragma unroll
                for (int bj = 0; bj < 2; ++bj) ldb(nb[bj][0], nb[bj][1], off2 + bj * HALF); }
#pragma unroll
            for (int bj = 0; bj < 2; ++bj) { const f32x4 x0 = cb[bj][0] + gv[bj][0] * acc[ai][bj][m][0], x1 = cb[bj][1] + gv[bj][1] * acc[ai][bj][m][1];
                if (OUT_BF16) *(u32x4*)((bf16_t*)out + off + bj * HALF) = pack8(x0, x1);
                else { *(f32x4*)((float*)out + off + bj * HALF) = x0; *(f32x4*)((float*)out + off + bj * HALF + 4) = x1; } }
            asm volatile("" ::: "memory"); }
    }
};
struct EpiInA {
    static constexpr bool PERM = true, AFTER_DRAIN = false;
    bf16_t *Q, *K, *V, *U, *GV; const float *qg, *kg; float* gvstat; float qscale;
    __device__ __forceinline__ void operator()(const f32x4 (&acc)[2][2][4][2], const Unit& u, int wr, int wc, int fr, int fq) const {
        const int row0 = u.pm * BM + wr * 64 + fr, ty = u.pn >> 2, pq = u.pn & 3;
        bf16_t* base = ty == 0 ? Q : ty == 1 ? K : ty == 2 ? V : ty == 3 ? U : GV;
        if (ty < 2) {
            const float* gp = (ty ? kg : qg) + 8 * fq; const float gsc = ty ? 1.0f : qscale;
            f32x4 gn[2][2];
#pragma unroll
            for (int bj = 0; bj < 2; ++bj)
#pragma unroll
                for (int n = 0; n < 2; ++n) gn[bj][n] = *(const f32x4*)(gp + 32 * bj + 4 * n) * gsc;
#pragma unroll
            for (int ai = 0; ai < 2; ++ai)
#pragma unroll
                for (int m = 0; m < 4; ++m) { bf16_t* rowp = base + (size_t)(row0 + ai * HALF + m * 16) * 1024 + pq * BM + 64 * wc + 8 * fq;
                    float ss = 0.f;
#pragma unroll
                    for (int bj = 0; bj < 2; ++bj)
#pragma unroll
                        for (int n = 0; n < 2; ++n) { const f32x4 x = acc[ai][bj][m][n]; ss += (x[0] * x[0] + x[1] * x[1]) + (x[2] * x[2] + x[3] * x[3]); }
                    ss += __shfl_xor(ss, 16); ss += __shfl_xor(ss, 32);
                    const float rstd = 1.0f / sqrtf(ss * (1.0f / 64.0f) + 1e-6f);
#pragma unroll
                    for (int bj = 0; bj < 2; ++bj) *(u32x4*)(rowp + 32 * bj) = pack8(acc[ai][bj][m][0] * rstd * gn[bj][0], acc[ai][bj][m][1] * rstd * gn[bj][1]); }
            return;
        }
        const bool act = ty >= 3, st = ty == 4;
#pragma unroll
        for (int ai = 0; ai < 2; ++ai)
#pragma unroll
            for (int m = 0; m < 4; ++m) { const int row = row0 + ai * HALF + m * 16; bf16_t* rowp = base + (size_t)row * 1024 + pq * BM + 32 * wc + 8 * fq;
                float s1 = 0.f, s2 = 0.f;
#pragma unroll
                for (int bj = 0; bj < 2; ++bj) { f32x4 v0 = acc[ai][bj][m][0], v1 = acc[ai][bj][m][1];
                    if (act) { f32x2 a = gelu_pk((f32x2){v0[0], v0[1]}), b = gelu_pk((f32x2){v0[2], v0[3]}), c = gelu_pk((f32x2){v1[0], v1[1]}), d = gelu_pk((f32x2){v1[2], v1[3]});
                        v0 = (f32x4){a.x, a.y, b.x, b.y}; v1 = (f32x4){c.x, c.y, d.x, d.y}; }
                    s1 += (v0[0] + v0[1]) + (v0[2] + v0[3]) + (v1[0] + v1[1]) + (v1[2] + v1[3]);
                    s2 += (v0[0] * v0[0] + v0[1] * v0[1]) + (v0[2] * v0[2] + v0[3] * v0[3]) + (v1[0] * v1[0] + v1[1] * v1[1]) + (v1[2] * v1[2] + v1[3] * v1[3]);
                    *(u32x4*)(rowp + HALF * bj) = pack8(v0, v1); }
                if (st) { s1 += __shfl_xor(s1, 16); s1 += __shfl_xor(s1, 32); s2 += __shfl_xor(s2, 16); s2 += __shfl_xor(s2, 32);
                    if (fq == 0) { atomicAdd(gvstat + 2 * (size_t)row, s1); atomicAdd(gvstat + 2 * (size_t)row + 1, s2); } } }
    }
};
struct EpiGate {
    static constexpr bool PERM = true, AFTER_DRAIN = false;
    bf16_t *GA, *GB;
    __device__ __forceinline__ void operator()(const f32x4 (&acc)[2][2][4][2], const Unit& u, int wr, int wc, int fr, int fq) const {
        const int row0 = u.pm * BM + wr * 64 + fr, pq = u.pn & 3;
        bf16_t* base = (u.pn >> 2) ? GB : GA;
#pragma unroll
        for (int ai = 0; ai < 2; ++ai)
#pragma unroll
            for (int m = 0; m < 4; ++m) { bf16_t* rowp = base + (size_t)(row0 + ai * HALF + m * 16) * 1024 + pq * BM + 32 * wc + 8 * fq;
#pragma unroll
                for (int bj = 0; bj < 2; ++bj) { f32x4 v0 = acc[ai][bj][m][0], v1 = acc[ai][bj][m][1];
#pragma unroll
                    for (int j = 0; j < 4; ++j) { v0[j] = sigmoidf_fast(v0[j]); v1[j] = sigmoidf_fast(v1[j]); }
                    *(u32x4*)(rowp + HALF * bj) = pack8(v0, v1); } }
    }
};
template <bool ADD> struct EpiProj {
    static constexpr bool PERM = true, AFTER_DRAIN = false;
    const bf16_t* G; bf16_t* MG; float dbg;
    __device__ __forceinline__ void operator()(const f32x4 (&acc)[2][2][4][2], const Unit& u, int wr, int wc, int fr, int fq) const {
        const int row0 = u.pm * BM + wr * 64 + fr, col0 = u.pn * BM + 32 * wc + 8 * fq;
        u32x4 ng[2], np[2];
#pragma unroll
        for (int bj = 0; bj < 2; ++bj) { ng[bj] = *(const u32x4*)(G + (size_t)row0 * 1024 + col0 + HALF * bj); np[bj] = ADD ? *(const u32x4*)(MG + (size_t)row0 * 1024 + col0 + HALF * bj) : (u32x4){0u, 0u, 0u, 0u}; }
#pragma unroll
        for (int gi = 0; gi < 8; ++gi) { const int ai = gi >> 2, m = gi & 3; const size_t off = (size_t)(row0 + ai * HALF + m * 16) * 1024 + col0;
            u32x4 cg[2], cp[2];
#pragma unroll
            for (int bj = 0; bj < 2; ++bj) { cg[bj] = ng[bj]; cp[bj] = np[bj]; }
            if (gi < 7) { const size_t off2 = (size_t)(row0 + ((gi + 1) >> 2) * HALF + ((gi + 1) & 3) * 16) * 1024 + col0;
#pragma unroll
                for (int bj = 0; bj < 2; ++bj) { ng[bj] = *(const u32x4*)(G + off2 + HALF * bj); if (ADD) np[bj] = *(const u32x4*)(MG + off2 + HALF * bj); } }
#pragma unroll
            for (int bj = 0; bj < 2; ++bj) { const u32x4 g = cg[bj];
                f32x4 v0 = acc[ai][bj][m][0], v1 = acc[ai][bj][m][1];
                v0[0] *= bflo(g.x); v0[1] *= bfhi(g.x); v0[2] *= bflo(g.y); v0[3] *= bfhi(g.y); v1[0] *= bflo(g.z); v1[1] *= bfhi(g.z); v1[2] *= bflo(g.w); v1[3] *= bfhi(g.w);
                if (ADD) { const u32x4 p = cp[bj];
                    v0[0] += bflo(p.x); v0[1] += bfhi(p.x); v0[2] += bflo(p.y); v0[3] += bfhi(p.y); v1[0] += bflo(p.z); v1[1] += bfhi(p.z); v1[2] += bflo(p.w); v1[3] += bfhi(p.w); }
                *(u32x4*)(MG + off + HALF * bj) = pack8(v0, v1); }
            asm volatile("" ::: "memory"); }
    }
};

template <class Epi, class Sched, bool ALIGN_EPI = false, bool SP2 = false>
__device__ __forceinline__ void gemm_phase(PG8_LAS unsigned char* lds, const Gemm g, const Sched& S, const Epi& E) {
    int tid_ = threadIdx.x; asm volatile("" : "+v"(tid_));
    const int tid = tid_, wid = __builtin_amdgcn_readfirstlane(tid >> 6), lane = tid & 63, wr = wid >> 2, wc = wid & 3, fr = lane & 15, fq = lane >> 4;
    const int K = g.K, nt = K / BK;
    unsigned voffA[2], voffB[2];
#pragma unroll
    for (int i = 0; i < 2; ++i) { int R, C; stage_rc(tid * 16 + i * 8192, R, C); const int Rb = Epi::PERM ? ((R & ~31) + perm32(R & 31)) : R;
        voffA[i] = (unsigned)(R * K + C) * 2u; voffB[i] = (unsigned)(Rb * K + C) * 2u; }
    const size_t kstep = (size_t)(BK * 2);
    const size_t hstep = (size_t)HALF * K * 2;
    const size_t tstep = 2 * hstep;
    const unsigned ldsw = (unsigned)wid * 1024u;
    const int aoff = lds_byte(wr * 64 + fr, fq * 8), boff = lds_byte(wc * 32 + fr, fq * 8);
#define PG8_SA(b, h) (((b) * 2 + (h)) * HTB)
#define PG8_SB(b, h) ((4 + (b) * 2 + (h)) * HTB)
#define PG8_STAGE(bufoff, gbase, voff) do { _Pragma("unroll") for (int _i = 0; _i < 2; ++_i) \
        __builtin_amdgcn_global_load_lds((const unsigned*)((const char*)(gbase) + (voff)[_i]), (PG8_LAS unsigned*)(lds + (bufoff) + ldsw + _i * 8192), 16, 0, 0); } while (0)
#define PG8_LDA(dst, b, h) do { _Pragma("unroll") for (int m = 0; m < 4; ++m) _Pragma("unroll") for (int k = 0; k < 2; ++k) dst[m][k] = *(const PG8_LAS bf16x8*)(lds + PG8_SA(b, h) + aoff + m * 2048 + k * 1024); } while (0)
#define PG8_LDB(dst, b, h) do { _Pragma("unroll") for (int n = 0; n < 2; ++n) _Pragma("unroll") for (int k = 0; k < 2; ++k) dst[n][k] = *(const PG8_LAS bf16x8*)(lds + PG8_SB(b, h) + boff + n * 2048 + k * 1024); } while (0)
#define PG8_MMA(ai, bj, At, Bt) do { __builtin_amdgcn_s_setprio(1); _Pragma("unroll") for (int m = 0; m < 4; ++m) _Pragma("unroll") for (int n = 0; n < 2; ++n) _Pragma("unroll") for (int k = 0; k < 2; ++k) \
        acc[ai][bj][m][n] = __builtin_amdgcn_mfma_f32_16x16x32_bf16(Bt[n][k], At[m][k], acc[ai][bj][m][n], 0, 0, 0); __builtin_amdgcn_s_setprio(0); } while (0)
#define PG8_WAIT_V(n) asm volatile("s_waitcnt vmcnt(" #n ")" ::: "memory")
#define PG8_WAIT_L(n) asm volatile("s_waitcnt lgkmcnt(" #n ")" ::: "memory")
#define PG8_BAR __builtin_amdgcn_s_barrier()
#define PG8_SCHED __builtin_amdgcn_sched_barrier(0)
    Unit cur, nxt; int ui = 0;
    if (!S.next(0, cur)) return;
    f32x4 acc[2][2][4][2];
#pragma unroll
    for (int a = 0; a < 2; ++a)
#pragma unroll
        for (int b = 0; b < 2; ++b)
#pragma unroll
            for (int m = 0; m < 4; ++m)
#pragma unroll
                for (int n = 0; n < 2; ++n) acc[a][b][m][n] = (f32x4){0.f, 0.f, 0.f, 0.f};
    bf16x8 At[4][2], B0[2][2], B1[2][2];
    const char* cA = (const char*)g.A + (size_t)cur.pm * tstep; const char* cB = (const char*)g.Bt + (size_t)cur.pn * tstep;
    S.a_ready(cur);
    if constexpr (SP2) {
        PG8_STAGE(PG8_SB(0, 0), cB, voffB); PG8_STAGE(PG8_SB(0, 1), cB + hstep, voffB); PG8_STAGE(PG8_SA(0, 0), cA, voffA); PG8_STAGE(PG8_SA(0, 1), cA + hstep, voffA);
        if (wr == 1) PG8_BAR;
        PG8_WAIT_V(2); PG8_BAR;
        PG8_STAGE(PG8_SB(1, 0), cB + kstep, voffB); PG8_STAGE(PG8_SA(1, 0), cA + kstep, voffA); PG8_STAGE(PG8_SB(1, 1), cB + hstep + kstep, voffB);
        PG8_WAIT_V(6); PG8_BAR;
    } else {
        PG8_STAGE(PG8_SB(0, 0), cB, voffB); PG8_STAGE(PG8_SA(0, 0), cA, voffA); PG8_STAGE(PG8_SB(0, 1), cB + hstep, voffB); PG8_STAGE(PG8_SA(0, 1), cA + hstep, voffA);
        if (wr == 1) PG8_BAR;
        PG8_WAIT_V(4); PG8_BAR;
        PG8_STAGE(PG8_SB(1, 0), cB + kstep, voffB); PG8_STAGE(PG8_SA(1, 0), cA + kstep, voffA); PG8_STAGE(PG8_SB(1, 1), cB + hstep + kstep, voffB);
        PG8_WAIT_V(6); PG8_BAR;
    }
    for (;;) {
        const bool has_next = S.next(ui + 1, nxt);
        const char* nA = has_next ? (const char*)g.A + (size_t)nxt.pm * tstep : cA; const char* nB = has_next ? (const char*)g.Bt + (size_t)nxt.pn * tstep : cB;
        for (int t = 0; t < nt; t += 2) {
            const bool last = (t == nt - 2);
            const char* a1 = cA + (size_t)(t + 1) * kstep;
            const char* a2 = last ? nA : cA + (size_t)(t + 2) * kstep; const char* b2 = last ? nB : cB + (size_t)(t + 2) * kstep;
            const char* a3 = a2 + kstep; const char* b3 = b2 + kstep;
            if (last && has_next) S.a_ready(nxt);
            if constexpr (SP2) {
            PG8_LDB(B0, 0, 0); PG8_LDB(B1, 0, 1); PG8_SCHED; PG8_LDA(At, 0, 0); PG8_STAGE(PG8_SA(1, 1), a1 + hstep, voffA);
            PG8_WAIT_V(8); PG8_WAIT_L(0); PG8_BAR; PG8_MMA(0, 0, At, B0); PG8_MMA(0, 1, At, B1); PG8_BAR; PG8_SCHED;
            PG8_LDA(At, 0, 1); PG8_STAGE(PG8_SB(0, 0), b2, voffB); PG8_STAGE(PG8_SB(0, 1), b2 + hstep, voffB); PG8_STAGE(PG8_SA(0, 0), a2, voffA);
            PG8_WAIT_V(8); PG8_WAIT_L(0); PG8_BAR; PG8_MMA(1, 0, At, B0); PG8_MMA(1, 1, At, B1); PG8_BAR; PG8_SCHED;
            PG8_LDB(B0, 1, 0); PG8_LDB(B1, 1, 1); PG8_SCHED; PG8_LDA(At, 1, 0); PG8_STAGE(PG8_SA(0, 1), a2 + hstep, voffA);
            PG8_WAIT_V(8); PG8_WAIT_L(0); PG8_BAR; PG8_MMA(0, 0, At, B0); PG8_MMA(0, 1, At, B1); PG8_BAR; PG8_SCHED;
            PG8_LDA(At, 1, 1); PG8_STAGE(PG8_SB(1, 0), b3, voffB); PG8_STAGE(PG8_SB(1, 1), b3 + hstep, voffB); PG8_STAGE(PG8_SA(1, 0), a3, voffA);
            PG8_WAIT_V(8); PG8_WAIT_L(0); PG8_BAR; PG8_MMA(1, 0, At, B0); PG8_MMA(1, 1, At, B1); PG8_BAR; PG8_SCHED;
            } else {
            PG8_LDB(B0, 0, 0); PG8_SCHED; PG8_LDA(At, 0, 0); PG8_STAGE(PG8_SA(1, 1), a1 + hstep, voffA);
            PG8_WAIT_L(8); PG8_BAR; PG8_WAIT_L(0); PG8_MMA(0, 0, At, B0); PG8_BAR; PG8_SCHED;
            PG8_LDB(B1, 0, 1); PG8_STAGE(PG8_SB(0, 0), b2, voffB);
            PG8_BAR; PG8_WAIT_L(0); PG8_MMA(0, 1, At, B1); PG8_BAR;
            PG8_LDA(At, 0, 1); PG8_STAGE(PG8_SA(0, 0), a2, voffA);
            PG8_BAR; PG8_WAIT_L(0); PG8_MMA(1, 0, At, B0); PG8_BAR; PG8_SCHED;
            PG8_STAGE(PG8_SB(0, 1), b2 + hstep, voffB);
            PG8_WAIT_V(6); PG8_BAR; PG8_MMA(1, 1, At, B1); PG8_BAR;
            PG8_LDB(B0, 1, 0); PG8_SCHED; PG8_LDA(At, 1, 0); PG8_STAGE(PG8_SA(0, 1), a2 + hstep, voffA);
            PG8_WAIT_L(8); PG8_BAR; PG8_WAIT_L(0); PG8_MMA(0, 0, At, B0); PG8_BAR; PG8_SCHED;
            PG8_LDB(B1, 1, 1); PG8_STAGE(PG8_SB(1, 0), b3, voffB);
            PG8_BAR; PG8_WAIT_L(0); PG8_MMA(0, 1, At, B1); PG8_BAR;
            PG8_LDA(At, 1, 1); PG8_STAGE(PG8_SA(1, 0), a3, voffA);
            PG8_BAR; PG8_WAIT_L(0); PG8_MMA(1, 0, At, B0); PG8_BAR; PG8_SCHED;
            PG8_STAGE(PG8_SB(1, 1), b3 + hstep, voffB);
            PG8_WAIT_V(6); PG8_BAR; PG8_MMA(1, 1, At, B1); PG8_BAR;
            }
        }
        if constexpr (ALIGN_EPI) { if (wr == 0) PG8_BAR; }
        if constexpr (!Epi::AFTER_DRAIN) { E(acc, cur, wr, wc, fr, fq); S.done(cur); }
        if (!has_next) break;
#pragma unroll
        for (int a = 0; a < 2; ++a)
#pragma unroll
            for (int b = 0; b < 2; ++b)
#pragma unroll
                for (int m = 0; m < 4; ++m)
#pragma unroll
                    for (int n = 0; n < 2; ++n) acc[a][b][m][n] = (f32x4){0.f, 0.f, 0.f, 0.f};
        cur = nxt; cA = nA; cB = nB; ++ui;
        if constexpr (ALIGN_EPI) { if (wr == 1) PG8_BAR; }
    }
    PG8_WAIT_V(0);
    if constexpr (!ALIGN_EPI) { if (wr == 0) PG8_BAR; }
    PG8_BAR;
    if constexpr (Epi::AFTER_DRAIN) { E.fused(acc, cur, wr, wc, fr, fq, lds, wid, lane); S.done(cur); }
#undef PG8_SA
#undef PG8_SB
#undef PG8_STAGE
#undef PG8_LDA
#undef PG8_LDB
#undef PG8_MMA
#undef PG8_WAIT_V
#undef PG8_WAIT_L
#undef PG8_BAR
#undef PG8_SCHED
}
}

#ifndef PG8_SP2
#define PG8_SP2 true
#endif
#ifndef PG8_ALIGN
#define PG8_ALIGN true
#endif
#define GAS __attribute__((address_space(1)))
#define LAS __attribute__((address_space(3)))
typedef unsigned short bf16;
typedef unsigned v4u __attribute__((ext_vector_type(4)));
typedef float f32x4 __attribute__((ext_vector_type(4)));
typedef short bf16x8 __attribute__((ext_vector_type(8)));
typedef GAS unsigned gu32;
typedef GAS unsigned long long gu64;
#define RLX_AGENT __ATOMIC_RELAXED, __HIP_MEMORY_SCOPE_AGENT
#define LDS_WAIT() asm volatile("s_waitcnt lgkmcnt(0)" ::: "memory")
#define VM_WAIT() asm volatile("s_waitcnt vmcnt(0)" ::: "memory")
__device__ __forceinline__ unsigned long long rt() { return __builtin_amdgcn_s_memrealtime(); }
__device__ __forceinline__ unsigned f2bf(float f) { unsigned u = __builtin_bit_cast(unsigned, f); return (u + 0x7fffu + ((u >> 16) & 1u)) >> 16; }
__device__ __forceinline__ unsigned pk2(float lo, float hi) { return f2bf(lo) | (f2bf(hi) << 16); }

#define XB_TMO      128
#define XB_XCNT(j)  (256  + 64 * (j))
#define XB_XSUB(j)  (1280 + 64 * (j))
#define XB_XGEN(j)  (2304 + 64 * (j))
#define XB_TOP      3328
#define XB_TOPGEN   3392
#define XCD_BAR_WORDS 3456
#define XB_SPIN_CAP (1u << 18)

__device__ __forceinline__ unsigned xb_ld(unsigned* p)              { return __hip_atomic_load(p, __ATOMIC_RELAXED, __HIP_MEMORY_SCOPE_AGENT); }
__device__ __forceinline__ unsigned xb_add(unsigned* p, unsigned v) { return __hip_atomic_fetch_add(p, v, __ATOMIC_RELAXED, __HIP_MEMORY_SCOPE_AGENT); }
__device__ __forceinline__ unsigned xb_xcc_id() { return (unsigned)__builtin_amdgcn_s_getreg((3 << 11) | 20) & 0xFu; }
#define XB_SPIN(cond, bar) do { unsigned _sp = 0; while (cond) { __builtin_amdgcn_s_sleep(1); \
    if ((++_sp & 255u) == 0u) { if (xb_ld(&(bar)[XB_TMO])) break; if (_sp > XB_SPIN_CAP) { atomicAdd(&(bar)[XB_TMO], 1u); break; } } } } while (0)

struct XcdBarrier {
    unsigned* bar; unsigned x;
    volatile LAS unsigned* st;
};

__device__ __forceinline__ XcdBarrier xcd_barrier_post(unsigned* bar, volatile LAS unsigned* st) {
    XcdBarrier b; b.bar = bar; b.x = xb_xcc_id(); b.st = st;
    if (threadIdx.x == 0) (void)xb_add(&bar[XB_XCNT(b.x)], 1u);
    return b;
}
__device__ __forceinline__ void xcd_barrier_complete(unsigned* bar, unsigned x, unsigned& nloc, unsigned& nx) {
    const unsigned G = gridDim.x * gridDim.y * gridDim.z;
    unsigned sum, cnt, mine, sp = 0u;
    for (;;) {
        sum = 0u; cnt = 0u; mine = 0u;
#pragma unroll
        for (unsigned j = 0; j < 16; ++j) { const unsigned c = xb_ld(&bar[XB_XCNT(j)]); sum += c; cnt += (c > 0u) ? 1u : 0u; mine = (j == x) ? c : mine; }
        if (sum == G) break;
        __builtin_amdgcn_s_sleep(1);
        if ((++sp & 255u) == 0u) { if (xb_ld(&bar[XB_TMO])) break; if (sp > XB_SPIN_CAP) { atomicAdd(&bar[XB_TMO], 1u); break; } }
    }
    nloc = mine > 0u ? mine : 1u; nx = cnt > 0u ? cnt : 1u;
}

__device__ __forceinline__ void xcd_barrier(const XcdBarrier& b) {
    asm volatile("s_waitcnt vmcnt(0)" ::: "memory");
    __syncthreads();
    if (threadIdx.x == 0) {
        unsigned* bar = b.bar;
        __builtin_amdgcn_s_waitcnt(0);
        unsigned nloc = b.st[0], nx = b.st[1];
        if (nloc == 0u) { xcd_barrier_complete(bar, b.x, nloc, nx); b.st[0] = nloc; b.st[1] = nx; }
        const unsigned old = xb_add(&bar[XB_XSUB(b.x)], 1u);
        const unsigned gen = old / nloc;
        if (old + 1u == (gen + 1u) * nloc) {
            __builtin_amdgcn_fence(__ATOMIC_RELEASE, "agent");
            asm volatile("s_waitcnt vmcnt(0)" ::: "memory");
            const unsigned og = xb_add(&bar[XB_TOP], 1u);
            const unsigned tg = og / nx;
            if (og + 1u == (tg + 1u) * nx) xb_add(&bar[XB_TOPGEN], 1u);
            else XB_SPIN(xb_ld(&bar[XB_TOPGEN]) == tg, bar);
            __builtin_amdgcn_fence(__ATOMIC_ACQUIRE, "agent");
            xb_add(&bar[XB_XGEN(b.x)], 1u);
            asm volatile("s_waitcnt vmcnt(0)" ::: "memory");
        } else {
            XB_SPIN(xb_ld(&bar[XB_XGEN(b.x)]) == gen, bar);
            __builtin_amdgcn_fence(__ATOMIC_ACQUIRE, "agent");
            asm volatile("s_waitcnt vmcnt(0)" ::: "memory");
        }
    }
    __syncthreads();
}

constexpr int NWAVES = 8;
constexpr int BATCH = 8, SEQ = 2048, D = 1024, M = BATCH * SEQ, FF = 2816, NGU = 2 * FF, NINA = 5120, NING = 2048, NMOD = 9216;
constexpr float EPS = 1e-6f, LOG2E = 1.4426950408889634f, QSCALE = 0.125f * LOG2E;
#ifndef MK_N_LAUNCHES
#define MK_N_LAUNCHES 1
#endif
constexpr int N_PHASES = 14;
#ifndef SKIP_MASK
#define SKIP_MASK 0
#endif
constexpr int N_LAUNCHES = MK_N_LAUNCHES;

constexpr size_t MiB = 1u << 20;
constexpr size_t WS_CTL = 0, CTL_ZERO_BYTES = 64 * 1024;
constexpr size_t WS_MOD = 1 * MiB;
constexpr size_t WS_BIAST = WS_MOD + 512 * 1024;
constexpr size_t WS_PAR = WS_BIAST + 8192;
constexpr size_t WS_WSP = WS_MOD + 768 * 1024;
constexpr size_t WS_GVSTAT = 2 * MiB;
constexpr size_t WS_WGU1 = 3 * MiB, WS_WD1 = WS_WGU1 + (size_t)NGU * D * 2, WS_WINA = WS_WD1 + (size_t)D * FF * 2, WS_WING = WS_WINA + (size_t)NINA * D * 2;
constexpr size_t WS_WA = WS_WING + (size_t)NING * D * 2, WS_WB = WS_WA + (size_t)D * D * 2, WS_WO = WS_WB + (size_t)D * D * 2;
constexpr size_t WS_WGU2 = WS_WO + (size_t)D * D * 2, WS_WD2 = WS_WGU2 + (size_t)NGU * D * 2, WS_WEND = WS_WD2 + (size_t)D * FF * 2;
constexpr size_t WS_XN = 56 * MiB;
constexpr size_t WS_ACT = 88 * MiB;
constexpr size_t ACT1 = (size_t)M * D * 2;
constexpr size_t WS_END = WS_ACT + 5 * ACT1;
static_assert(WS_WEND <= WS_XN && WS_XN + ACT1 <= WS_ACT && WS_END <= 256 * MiB && (size_t)M * FF * 2 <= 3 * ACT1, "d_ws map");
constexpr int CW_BAR = 1024;

constexpr int RING_OFF = 0, RING_BYTES = 131072;
constexpr int LDSCTL_OFF = RING_BYTES, MISC_OFF = LDSCTL_OFF + 320;
constexpr int LDS_BYTES = 147456;
constexpr int L_XCH = 98304, L_BIAS = 132096, L_WSF = 133120;

typedef float f32x16 __attribute__((ext_vector_type(16)));
typedef short s16x4 __attribute__((ext_vector_type(4)));
typedef unsigned v2u __attribute__((ext_vector_type(2)));
typedef short v4i16_t __attribute__((ext_vector_type(4)));

struct Args { const float* in[26]; float* out; unsigned char* ws; int ph_lo, ph_hi, li, pad; };
struct Frame {
    LAS unsigned char* lds;
    volatile LAS unsigned* MISC;
    gu32* ctl;
    int tid, lane, wave, vcu, G;
    const Args* a;
    unsigned char* ws;
    float* out;
};
#define IN_PTR(name, k) __device__ __forceinline__ const float* name(const Frame& F) { return F.a->in[k]; }
IN_PTR(p_x, 0) IN_PTR(p_c, 1) IN_PTR(p_w_ada, 2) IN_PTR(p_b_ada, 3) IN_PTR(p_w1g, 4) IN_PTR(p_w1u, 5) IN_PTR(p_w1d, 6) IN_PTR(p_w_in, 7) IN_PTR(p_q_g, 8) IN_PTR(p_k_g, 9)
IN_PTR(p_lq1, 10) IN_PTR(p_lk1, 11) IN_PTR(p_lq2, 12) IN_PTR(p_lk2, 13) IN_PTR(p_sub_g, 14) IN_PTR(p_relb, 15) IN_PTR(p_ln_g, 16) IN_PTR(p_ln_b, 17) IN_PTR(p_w_sp, 18) IN_PTR(p_b_sp, 19)
IN_PTR(p_w_a, 20) IN_PTR(p_w_b, 21) IN_PTR(p_w_o, 22) IN_PTR(p_w2g, 23) IN_PTR(p_w2u, 24) IN_PTR(p_w2d, 25)
#define WS_F32(name, off) __device__ __forceinline__ float* name(const Frame& F) { return (float*)(F.ws + (off)); }
#define WS_B16(name, off) __device__ __forceinline__ bf16* name(const Frame& F) { return (bf16*)(F.ws + (off)); }
WS_F32(p_MOD, WS_MOD) WS_F32(p_BIAST, WS_BIAST) WS_F32(p_PAR, WS_PAR) WS_F32(p_GVSTAT, WS_GVSTAT)
WS_B16(p_WSP, WS_WSP) WS_B16(p_WGU1, WS_WGU1) WS_B16(p_WD1, WS_WD1) WS_B16(p_WINA, WS_WINA) WS_B16(p_WING, WS_WING) WS_B16(p_WA, WS_WA) WS_B16(p_WB, WS_WB) WS_B16(p_WO, WS_WO) WS_B16(p_WGU2, WS_WGU2) WS_B16(p_WD2, WS_WD2)
__device__ __forceinline__ bf16* p_X1B(const Frame& F) { return (bf16*)F.out; }
WS_B16(p_X2B, WS_ACT + 3 * ACT1)
WS_B16(p_XN, WS_XN) WS_B16(p_Q, WS_ACT) WS_B16(p_K, WS_ACT + ACT1) WS_B16(p_V, WS_ACT + 2 * ACT1) WS_B16(p_U, WS_ACT + 3 * ACT1) WS_B16(p_GV, WS_ACT + 4 * ACT1) WS_B16(p_H, WS_ACT)


__device__ __forceinline__ float wave_sum(float v) {
#pragma unroll
    for (int o = 1; o < 64; o <<= 1) v += __shfl_xor(v, o);
    return v;
}
__device__ __forceinline__ float wave_max(float v) {
#pragma unroll
    for (int o = 1; o < 64; o <<= 1) v = fmaxf(v, __shfl_xor(v, o));
    return v;
}
__device__ __forceinline__ float bflo(unsigned w) { return __uint_as_float(w << 16); }
__device__ __forceinline__ float bfhi(unsigned w) { return __uint_as_float(w & 0xffff0000u); }

__device__ __forceinline__ void p0_transpose_item(const float* W, int ldw, int K, bf16* WT, int rowbase, int k0, int n0, LAS float* scr, int lane) {
    float tv[32];
#pragma unroll
    for (int i = 0; i < 32; ++i) tv[i] = W[(size_t)(k0 + 2 * i + (lane >> 5)) * ldw + n0 + (lane & 31)];
#pragma unroll
    for (int i = 0; i < 32; ++i) scr[(2 * i + (lane >> 5)) * 33 + (lane & 31)] = tv[i];
    LDS_WAIT(); asm volatile("" ::: "memory");
    const int c = lane & 7;
#pragma unroll
    for (int j = 0; j < 4; ++j) { const int n = (lane >> 3) + 8 * j; const LAS float* s = scr + (8 * c) * 33 + n;
        v4u o; o.x = pk2(s[0 * 33], s[1 * 33]); o.y = pk2(s[2 * 33], s[3 * 33]); o.z = pk2(s[4 * 33], s[5 * 33]); o.w = pk2(s[6 * 33], s[7 * 33]);
        *(GAS v4u*)(WT + (size_t)(rowbase + n) * K + k0 + 8 * c) = o; }
    LDS_WAIT(); asm volatile("" ::: "memory");
}
__device__ __forceinline__ void p0_tr_plain(const float* W, int K, int N, bf16* WT, int item, LAS float* scr, int lane) {
    const int nblk = N / 32, kb = item / nblk, nb = item % nblk;
    p0_transpose_item(W, N, K, WT, 32 * nb, 64 * kb, 32 * nb, scr, lane);
}
__device__ __forceinline__ void p0_tr_gu(const float* W, bf16* WT, int up, int item, LAS float* scr, int lane) {
    const int nblk = FF / 32, kb = item / nblk, nb = item % nblk, n0 = 32 * nb;
    p0_transpose_item(W, FF, D, WT, 256 * (n0 >> 7) + 128 * up + (n0 & 127), 64 * kb, n0, scr, lane);
}
__device__ __forceinline__ void p0_tr_in(Frame& F, int item, LAS float* scr, int lane) {
    const int nblk = 7168 / 32, kb = item / nblk, nb = item % nblk, n0 = 32 * nb;
    bf16* WT = p_WINA(F); int rb = n0;
    if (n0 < 2048) rb = (n0 & ~255) + 128 * ((n0 & 63) >> 5) + 32 * ((n0 & 255) >> 6);
    else if (n0 >= NINA) { WT = p_WING(F); rb = n0 - NINA; }
    p0_transpose_item(p_w_in(F), 7168, D, WT, rb, 64 * kb, n0, scr, lane);
}
__device__ __forceinline__ void p0_prologue(Frame& F) {
    {
        LAS float* sl = (LAS float*)(F.lds);
        LAS float* red = sl + 8192;
        for (int i = F.tid; i < 8192; i += NWAVES * 64) { const float v = p_c(F)[i]; sl[i] = v / (1.0f + __expf(-v)); }
        __syncthreads();
        const int cl = F.tid % 36, kl = F.tid / 36;
        for (int item = F.vcu; item < 256; item += F.G) {
            const int n0 = item * 36;
            if (kl < 14) {
                float a0 = 0.f, a1 = 0.f, a2 = 0.f, a3 = 0.f, a4 = 0.f, a5 = 0.f, a6 = 0.f, a7 = 0.f;
                const float* wp = p_w_ada(F) + n0 + cl;
                for (int k0 = kl; k0 < 1024; k0 += 14 * 8) {
                    float w[8];
#pragma unroll
                    for (int u = 0; u < 8; ++u) { const int k = k0 + 14 * u; w[u] = wp[(size_t)(k < 1024 ? k : 1023) * NMOD]; }
#pragma unroll
                    for (int u = 0; u < 8; ++u) { const int k = k0 + 14 * u; const int kc = k < 1024 ? k : 1023; const float wv = k < 1024 ? w[u] : 0.f;
                        a0 += sl[kc] * wv; a1 += sl[1024 + kc] * wv; a2 += sl[2048 + kc] * wv; a3 += sl[3072 + kc] * wv; a4 += sl[4096 + kc] * wv; a5 += sl[5120 + kc] * wv; a6 += sl[6144 + kc] * wv; a7 += sl[7168 + kc] * wv; } }
                LAS float* r = red + kl * 288 + cl;
                r[0] = a0; r[36] = a1; r[72] = a2; r[108] = a3; r[144] = a4; r[180] = a5; r[216] = a6; r[252] = a7;
            }
            __syncthreads();
            if (F.tid < 288) { float s = p_b_ada(F)[n0 + (F.tid % 36)];
#pragma unroll
                for (int q = 0; q < 14; ++q) s += red[q * 288 + F.tid];
                p_MOD(F)[(size_t)(F.tid / 36) * NMOD + n0 + (F.tid % 36)] = s; }
            __syncthreads();
        }
    }
    if (F.vcu == 0) {
        if (F.wave == 0) {
            const float a = wave_sum(p_lq1(F)[F.lane] * p_lk1(F)[F.lane]), b = wave_sum(p_lq2(F)[F.lane] * p_lk2(F)[F.lane]);
            if (F.lane == 0) p_PAR(F)[0] = __expf(a) - __expf(b) + 0.2f;
        } else {
            const float gq = wave_max(fabsf(p_q_g(F)[F.lane])), gk = wave_max(fabsf(p_k_g(F)[F.lane]));
            for (int h = F.wave - 1; h < 8; h += 7) {
                const float tb = wave_max(F.lane < 32 ? fabsf(p_relb(F)[F.lane * 8 + h]) : 0.f);
                const float bound2 = (1.02f * 8.0f * gq * gk + 2.0f * tb) * LOG2E;
                const float xs = fmaxf(bound2 - 100.0f, 0.0f);
                if (F.lane == 0) p_PAR(F)[8 + h] = xs;
                for (int n = F.lane; n <= 128; n += 64) {
                    int bk = n;
                    if (n >= 16) { bk = 16 + (int)(logf((float)n / 16.0f) / logf(8.0f) * 16.0f); bk = bk > 31 ? 31 : bk; }
                    p_BIAST(F)[h * 160 + n] = (p_relb(F)[bk * 8 + h] - p_relb(F)[31 * 8 + h]) * LOG2E - xs;
                }
            }
        }
    }
    for (int i = F.vcu * (NWAVES * 64) + F.tid; i < 2 * M; i += F.G * NWAVES * 64) p_GVSTAT(F)[i] = 0.f;
    for (int i = F.vcu * (NWAVES * 64) + F.tid; i < 8 * 128 * 128; i += F.G * NWAVES * 64) {
        const int s = i & 127, t = (i >> 7) & 127; p_WSP(F)[i] = (s <= t) ? (bf16)f2bf(p_w_sp(F)[i]) : (bf16)0; }
    LAS float* scr = (LAS float*)(F.lds + RING_OFF + F.wave * 16384);
    __syncthreads();
    const int gw = F.vcu * NWAVES + F.wave, NGW = F.G * NWAVES;
    constexpr int I_GU = (D / 64) * (FF / 32), I_D = (FF / 64) * (D / 32), I_P = (D / 64) * (D / 32);
    constexpr int NITEMS = 4 * I_GU;
    for (int it = gw; it < NITEMS; it += NGW) {
        int r = it;
        if (r < I_GU) { p0_tr_gu(p_w1g(F), p_WGU1(F), 0, r, scr, F.lane); continue; } r -= I_GU;
        if (r < I_GU) { p0_tr_gu(p_w1u(F), p_WGU1(F), 1, r, scr, F.lane); continue; } r -= I_GU;
        if (r < I_GU) { p0_tr_gu(p_w2g(F), p_WGU2(F), 0, r, scr, F.lane); continue; } r -= I_GU;
        p0_tr_gu(p_w2u(F), p_WGU2(F), 1, r, scr, F.lane);
    }
}
__device__ __forceinline__ void p2_tail_convert(Frame& F, int first_idle) {
    LAS float* scr = (LAS float*)(F.lds + RING_OFF + F.wave * 16384);
    constexpr int I_D = (FF / 64) * (D / 32), I_IN = (D / 64) * (7168 / 32), I_P = (D / 64) * (D / 32);
    const int nw = (F.G - first_idle) * NWAVES;
    for (int it = ((int)blockIdx.x - first_idle) * NWAVES + F.wave; it < I_D + I_IN + 3 * I_P; it += nw) {
        int r = it;
        if (r < I_D) { p0_tr_plain(p_w1d(F), FF, D, p_WD1(F), r, scr, F.lane); continue; } r -= I_D;
        if (r < I_IN) { p0_tr_in(F, r, scr, F.lane); continue; } r -= I_IN;
        if (r < I_P) { p0_tr_plain(p_w_a(F), D, D, p_WA(F), r, scr, F.lane); continue; } r -= I_P;
        if (r < I_P) { p0_tr_plain(p_w_b(F), D, D, p_WB(F), r, scr, F.lane); continue; } r -= I_P;
        p0_tr_plain(p_w_o(F), D, D, p_WO(F), r, scr, F.lane);
    }
}

__device__ __forceinline__ void p12_tail_convert(Frame& F, int first_idle) {
    LAS float* scr = (LAS float*)(F.lds + RING_OFF + F.wave * 16384);
    constexpr int I_D = (FF / 64) * (D / 32);
    const int nw = (F.G - first_idle) * NWAVES;
    for (int it = ((int)blockIdx.x - first_idle) * NWAVES + F.wave; it < I_D; it += nw) p0_tr_plain(p_w2d(F), FF, D, p_WD2(F), it, scr, F.lane);
}

__device__ __forceinline__ void norm_rows(Frame& F, const float* src, int sub) {
    const int gw = F.vcu * NWAVES + F.wave, NGW = F.G * NWAVES;
    for (int base = gw * 8; base < M; base += NGW * 8) {
        const float* sh = p_MOD(F) + (size_t)(base >> 11) * NMOD + (3 * sub) * 1024; const float* sc = sh + 1024;
        f32x4 a[4], b[4];
#pragma unroll
        for (int j = 0; j < 4; ++j) { a[j] = *((const GAS f32x4*)sc + F.lane + 64 * j) + 1.0f; b[j] = *((const GAS f32x4*)sh + F.lane + 64 * j); }
#pragma unroll
        for (int half = 0; half < 2; ++half) {
            f32x4 v[4][4]; float s[4];
#pragma unroll
            for (int r = 0; r < 4; ++r) { const GAS f32x4* xr = (const GAS f32x4*)(src + (size_t)(base + 4 * half + r) * D) + F.lane;
#pragma unroll
                for (int j = 0; j < 4; ++j) v[r][j] = xr[64 * j]; }
#pragma unroll
            for (int r = 0; r < 4; ++r) { float t = 0.f;
#pragma unroll
                for (int j = 0; j < 4; ++j) t += (v[r][j].x * v[r][j].x + v[r][j].y * v[r][j].y) + (v[r][j].z * v[r][j].z + v[r][j].w * v[r][j].w);
                s[r] = t; }
#pragma unroll
            for (int o = 1; o < 64; o <<= 1) {
#pragma unroll
                for (int r = 0; r < 4; ++r) s[r] += __shfl_xor(s[r], o); }
#pragma unroll
            for (int r = 0; r < 4; ++r) { const float rstd = 1.0f / sqrtf(s[r] * (1.f / D) + EPS);
                GAS unsigned long long* o8 = (GAS unsigned long long*)(p_XN(F) + (size_t)(base + 4 * half + r) * D) + F.lane;
#pragma unroll
                for (int j = 0; j < 4; ++j) { const f32x4 o = v[r][j] * rstd * a[j] + b[j];
                    o8[64 * j] = (unsigned long long)pk2(o.x, o.y) | ((unsigned long long)pk2(o.z, o.w) << 32); } }
        }
    }
}
template <int R> __device__ __forceinline__ void norm_rows_b16(Frame& F, const bf16* src, int sub) {
    const int gw = F.vcu * NWAVES + F.wave, NGW = F.G * NWAVES, lane = F.lane;
    for (int base = gw * 8; base < M; base += NGW * 8) {
        const float* sh = p_MOD(F) + (size_t)(base >> 11) * NMOD + (3 * sub) * 1024 + lane * 16; const float* sc = sh + 1024;
        f32x4 a[4], b[4];
#pragma unroll
        for (int j = 0; j < 4; ++j) { a[j] = *((const GAS f32x4*)sc + j) + 1.0f; b[j] = *((const GAS f32x4*)sh + j); }
#pragma unroll 1
        for (int half = 0; half < 8 / R; ++half) {
            v4u w0[R], w1[R]; float s[R];
#pragma unroll
            for (int r = 0; r < R; ++r) { const bf16* p = src + (size_t)(base + R * half + r) * D + lane * 16; w0[r] = *(const GAS v4u*)p; w1[r] = *(const GAS v4u*)(p + 8); }
            f32x4 v[R][4];
#pragma unroll
            for (int r = 0; r < R; ++r) { v[r][0] = (f32x4){bflo(w0[r].x), bfhi(w0[r].x), bflo(w0[r].y), bfhi(w0[r].y)}; v[r][1] = (f32x4){bflo(w0[r].z), bfhi(w0[r].z), bflo(w0[r].w), bfhi(w0[r].w)};
                v[r][2] = (f32x4){bflo(w1[r].x), bfhi(w1[r].x), bflo(w1[r].y), bfhi(w1[r].y)}; v[r][3] = (f32x4){bflo(w1[r].z), bfhi(w1[r].z), bflo(w1[r].w), bfhi(w1[r].w)};
                float t = 0.f;
#pragma unroll
                for (int j = 0; j < 4; ++j) t += (v[r][j].x * v[r][j].x + v[r][j].y * v[r][j].y) + (v[r][j].z * v[r][j].z + v[r][j].w * v[r][j].w);
                s[r] = t; }
#pragma unroll
            for (int o = 1; o < 64; o <<= 1) {
#pragma unroll
                for (int r = 0; r < R; ++r) s[r] += __shfl_xor(s[r], o); }
#pragma unroll
            for (int r = 0; r < R; ++r) { const float rstd = 1.0f / sqrtf(s[r] * (1.f / D) + EPS);
                f32x4 o[4];
#pragma unroll
                for (int j = 0; j < 4; ++j) o[j] = v[r][j] * rstd * a[j] + b[j];
                bf16* q = p_XN(F) + (size_t)(base + R * half + r) * D + lane * 16;
                v4u x0, x1; x0.x = pk2(o[0].x, o[0].y); x0.y = pk2(o[0].z, o[0].w); x0.z = pk2(o[1].x, o[1].y); x0.w = pk2(o[1].z, o[1].w); x1.x = pk2(o[2].x, o[2].y); x1.y = pk2(o[2].z, o[2].w); x1.z = pk2(o[3].x, o[3].y); x1.w = pk2(o[3].z, o[3].w);
                *(GAS v4u*)q = x0; *(GAS v4u*)(q + 8) = x1; }
        }
    }
}
__device__ __forceinline__ void qknorm_rows(Frame& F) {
    const int gw = F.vcu * NWAVES + F.wave, NGW = F.G * NWAVES, lane = F.lane;
    float gq[16], gk[16];
#pragma unroll
    for (int e = 0; e < 16; ++e) { gq[e] = p_q_g(F)[(lane & 3) * 16 + e] * QSCALE; gk[e] = p_k_g(F)[(lane & 3) * 16 + e]; }
    for (int m = gw; m < M; m += NGW) {
#pragma unroll
        for (int w = 0; w < 2; ++w) {
            bf16* p = (w ? p_K(F) : p_Q(F)) + (size_t)m * D + lane * 16;
            const v4u a = *(const GAS v4u*)p, b = *(const GAS v4u*)(p + 8);
            float x[16] = {bflo(a.x), bfhi(a.x), bflo(a.y), bfhi(a.y), bflo(a.z), bfhi(a.z), bflo(a.w), bfhi(a.w), bflo(b.x), bfhi(b.x), bflo(b.y), bfhi(b.y), bflo(b.z), bfhi(b.z), bflo(b.w), bfhi(b.w)};
            float s = 0.f;
#pragma unroll
            for (int e = 0; e < 16; ++e) s += x[e] * x[e];
            s += __shfl_xor(s, 1); s += __shfl_xor(s, 2);
            const float rstd = 1.0f / sqrtf(s * (1.f / 64.f) + EPS);
#pragma unroll
            for (int e = 0; e < 16; ++e) x[e] = x[e] * rstd * (w ? gk[e] : gq[e]);
            v4u oa, ob; oa.x = pk2(x[0], x[1]); oa.y = pk2(x[2], x[3]); oa.z = pk2(x[4], x[5]); oa.w = pk2(x[6], x[7]); ob.x = pk2(x[8], x[9]); ob.y = pk2(x[10], x[11]); ob.z = pk2(x[12], x[13]); ob.w = pk2(x[14], x[15]);
            *(GAS v4u*)p = oa; *(GAS v4u*)(p + 8) = ob;
        }
        {
            const bf16* p = p_GV(F) + (size_t)m * D + lane * 16;
            const v4u a = *(const GAS v4u*)p, b = *(const GAS v4u*)(p + 8);
            const float x[16] = {bflo(a.x), bfhi(a.x), bflo(a.y), bfhi(a.y), bflo(a.z), bfhi(a.z), bflo(a.w), bfhi(a.w), bflo(b.x), bfhi(b.x), bflo(b.y), bfhi(b.y), bflo(b.z), bfhi(b.z), bflo(b.w), bfhi(b.w)};
            float s = 0.f;
#pragma unroll
            for (int e = 0; e < 16; ++e) s += x[e];
            const float mean = wave_sum(s) * (1.f / D); float q = 0.f;
#pragma unroll
            for (int e = 0; e < 16; ++e) { const float d = x[e] - mean; q += d * d; }
            const float rstd = 1.0f / sqrtf(wave_sum(q) * (1.f / D) + EPS);
            if (lane == 0) { p_GVSTAT(F)[2 * (size_t)m] = mean; p_GVSTAT(F)[2 * (size_t)m + 1] = rstd; }
        }
    }
}

__device__ __forceinline__ int crow(int r, int hi) { return (r & 3) + 8 * (r >> 2) + 4 * hi; }
__device__ __forceinline__ s16x4 vtr(const LAS unsigned char* p) { return __builtin_bit_cast(s16x4, __builtin_amdgcn_ds_read_tr16_b64_v4i16((LAS v4i16_t*)p)); }
__device__ __forceinline__ bf16x8 pack8f(const f32x16& p, int b) {
    v4u w; w.x = pg8::cvt_pk_bf16(p[b], p[b + 1]); w.y = pg8::cvt_pk_bf16(p[b + 2], p[b + 3]); w.z = pg8::cvt_pk_bf16(p[b + 4], p[b + 5]); w.w = pg8::cvt_pk_bf16(p[b + 6], p[b + 7]);
    return __builtin_bit_cast(bf16x8, w);
}
__device__ __forceinline__ void glds16s(const void* sbase, unsigned voff, unsigned lds_dst) {
    unsigned keep;
    asm volatile("s_mov_b32 %0, m0\n\ts_mov_b32 m0, %3\n\ts_nop 0\n\tglobal_load_lds_dwordx4 %1, %2\n\ts_mov_b32 m0, %0" : "=&s"(keep) : "v"(voff), "s"(sbase), "s"(lds_dst) : "memory");
}
#define ATT_WAIT_BAR(N) asm volatile("s_waitcnt vmcnt(" #N ") lgkmcnt(0)\n\ts_barrier" ::: "memory")
struct AttnDma { unsigned ko[2], vo[2]; };
__device__ __forceinline__ AttnDma attn_dma_setup(int wid, int lane) {
    AttnDma d;
#pragma unroll
    for (int i = 0; i < 2; ++i) { const int p = wid + 8 * i; const int kv = 4 * p + (lane >> 4), ch = (lane & 15) ^ (kv & 15);
        d.ko[i] = (unsigned)((kv * D + ch * 8) * 2);
        const int kv2 = 16 * (p & 3) + (lane >> 2);
        d.vo[i] = (unsigned)((kv2 * D + (p >> 2) * 32 + (lane & 3) * 8) * 2); }
    return d;
}
__device__ __forceinline__ void attn_dma_tile(LAS unsigned char* lds, int buf, const bf16* Kg, const bf16* Vg, int t, int wid, const AttnDma& d) {
    const unsigned kb = (unsigned)(size_t)lds + (unsigned)buf * 32768u, vb = kb + 16384u;
    const bf16* kt = Kg + (size_t)(64 * t) * D; const bf16* vt = Vg + (size_t)(64 * t) * D;
#pragma unroll
    for (int i = 0; i < 2; ++i) { const int p = wid + 8 * i;
        glds16s(kt, d.ko[i], (unsigned)__builtin_amdgcn_readfirstlane(kb + p * 1024));
        glds16s(vt, d.vo[i], (unsigned)__builtin_amdgcn_readfirstlane(vb + p * 1024)); }
}
template <bool SLOW> __device__ __forceinline__ void attn_tile(const LAS unsigned char* kb, const LAS unsigned char* vp, const LAS float* biasL, const bf16x8 (&qr)[4], f32x16 (&o)[4], float& l,
                                                                int map, int r32, int hi, int nbase  ) {
    f32x16 p0 = f32x16{}, p1 = f32x16{};
#pragma unroll
    for (int d0 = 0; d0 < 4; ++d0) { const int ch = map * 8 + 2 * d0 + hi, sw = (ch ^ (r32 & 15)) << 4;
        const bf16x8 k0 = *(const LAS bf16x8*)(kb + r32 * 256 + sw), k1 = *(const LAS bf16x8*)(kb + (r32 + 32) * 256 + sw);
        p0 = __builtin_amdgcn_mfma_f32_32x32x16_bf16(k0, qr[d0], p0, 0, 0, 0); p1 = __builtin_amdgcn_mfma_f32_32x32x16_bf16(k1, qr[d0], p1, 0, 0, 0); }
    float s = 0.f;
    if (SLOW) {
#pragma unroll
        for (int r = 0; r < 16; ++r) { const int n0 = nbase - crow(r, hi), n1 = n0 - 32;
            const float b0 = biasL[min(max(n0, 0), 128)], b1 = biasL[min(max(n1, 0), 128)];
            float e0 = __builtin_amdgcn_exp2f(p0[r] + b0), e1 = __builtin_amdgcn_exp2f(p1[r] + b1);
            e0 = n0 >= 0 ? e0 : 0.f; e1 = n1 >= 0 ? e1 : 0.f;
            p0[r] = e0; p1[r] = e1; s += e0 + e1; }
    } else {
#pragma unroll
        for (int r = 0; r < 16; ++r) { const float e0 = __builtin_amdgcn_exp2f(p0[r]), e1 = __builtin_amdgcn_exp2f(p1[r]); p0[r] = e0; p1[r] = e1; s += e0 + e1; }
    }
    l += s;
    const bf16x8 pw0 = pack8f(p0, 0), pw1 = pack8f(p0, 8), pw2 = pack8f(p1, 0), pw3 = pack8f(p1, 8);
#pragma unroll
    for (int d0 = 0; d0 < 4; ++d0) {
#define VF(ks) ({ const s16x4 lo_ = vtr(vp + d0 * 4096 + (ks) * 1024), hh_ = vtr(vp + d0 * 4096 + (ks) * 1024 + 512); (bf16x8){lo_[0], lo_[1], lo_[2], lo_[3], hh_[0], hh_[1], hh_[2], hh_[3]}; })
        o[d0] = __builtin_amdgcn_mfma_f32_32x32x16_bf16(pw0, VF(0), o[d0], 0, 0, 0);
        o[d0] = __builtin_amdgcn_mfma_f32_32x32x16_bf16(pw1, VF(1), o[d0], 0, 0, 0);
        o[d0] = __builtin_amdgcn_mfma_f32_32x32x16_bf16(pw2, VF(2), o[d0], 0, 0, 0);
        o[d0] = __builtin_amdgcn_mfma_f32_32x32x16_bf16(pw3, VF(3), o[d0], 0, 0, 0);
#undef VF
    }
}
__device__ __forceinline__ void attn_units(Frame& F, int b, int h, int s) {
    const int tid = F.tid, lane = F.lane, r32 = lane & 31, hi = lane >> 5, wid = F.wave, map = wid >> 2, wq = wid & 3;
    LAS unsigned char* lds = F.lds;
    LAS float* biasL = (LAS float*)(lds + L_BIAS);
    LAS float* wsf = (LAS float*)(lds + L_WSF) + wid * 64;
    LAS unsigned* xw = (LAS unsigned*)(lds + L_XCH) + wq * 2048;
    const size_t rowbase = (size_t)b * SEQ;
    const bf16* Kg = p_K(F) + rowbase * D + h * 128; const bf16* Vg = p_V(F) + rowbase * D + h * 128;
    const bf16* Qg = p_Q(F) + (rowbase + wq * 32 + r32) * D + h * 128 + map * 64 + hi * 8;
    const AttnDma dd = attn_dma_setup(wid, lane);
    const int voff = ((lane >> 4) & 1) * 32 + (lane & 3) * 8 + (4 * hi + ((lane & 15) >> 2)) * 64;
    __syncthreads();
    attn_dma_tile(lds, 0, Kg, Vg, 0, wid, dd);
    attn_dma_tile(lds, 1, Kg, Vg, 1, wid, dd);
    if (tid < 129) biasL[tid] = p_BIAST(F)[h * 160 + tid];
    const bool slow_all = p_PAR(F)[8 + h] != 0.0f;
    const float lam = p_PAR(F)[0];
    float gs[4];
#pragma unroll
    for (int d0 = 0; d0 < 4; ++d0) gs[d0] = p_sub_g(F)[32 * d0 + r32] * 0.8f;
    bf16x8 qr[4];
#pragma unroll
    for (int d0 = 0; d0 < 4; ++d0) qr[d0] = __builtin_bit_cast(bf16x8, *(const GAS v4u*)(Qg + (size_t)(128 * s) * D + d0 * 16));
#pragma unroll 1
    for (int ui = 0; ui < 4; ++ui) {
        const int qb = ui == 0 ? s : ui == 1 ? 7 - s : ui == 2 ? 8 + s : 15 - s, q0 = qb * 128, NT = 2 * (qb + 1), qpos = q0 + wq * 32 + r32;
        asm volatile("" : "+v"(qr[0]), "+v"(qr[1]), "+v"(qr[2]), "+v"(qr[3]));
        f32x16 o[4];
#pragma unroll
        for (int i = 0; i < 4; ++i) o[i] = f32x16{};
        float l = 0.f;
        const int nfast = slow_all ? 0 : (NT - 4 > 0 ? NT - 4 : 0);
        int t = 0, bufc = 0;
        for (; t < nfast; ++t) {
            ATT_WAIT_BAR(4);
            attn_dma_tile(lds, bufc == 0 ? 2 : bufc - 1, Kg, Vg, t + 2, wid, dd);
            const LAS unsigned char* kb = lds + bufc * 32768;
            attn_tile<false>(kb, kb + 16384 + voff, biasL, qr, o, l, map, r32, hi, qpos - 64 * t);
            bufc = bufc == 2 ? 0 : bufc + 1;
        }
        for (; t < NT; ++t) {
            if (t + 1 < NT) ATT_WAIT_BAR(4); else ATT_WAIT_BAR(0);
            if (t + 2 < NT) attn_dma_tile(lds, bufc == 0 ? 2 : bufc - 1, Kg, Vg, t + 2, wid, dd);
            const LAS unsigned char* kb = lds + bufc * 32768;
            attn_tile<true>(kb, kb + 16384 + voff, biasL, qr, o, l, map, r32, hi, qpos - 64 * t);
            bufc = bufc == 2 ? 0 : bufc + 1;
        }
        l += __shfl_xor(l, 32);
        if (hi == 0) wsf[r32] = map ? lam / l : 1.0f / l;
        LDS_WAIT();
        __syncthreads();
        if (ui < 3) { const int qn = ui == 0 ? 7 - s : ui == 1 ? 8 + s : 15 - s;
            attn_dma_tile(lds, 0, Kg, Vg, 0, wid, dd);
            attn_dma_tile(lds, 1, Kg, Vg, 1, wid, dd);
#pragma unroll
            for (int d0 = 0; d0 < 4; ++d0) qr[d0] = __builtin_bit_cast(bf16x8, *(const GAS v4u*)(Qg + (size_t)(128 * qn) * D + d0 * 16)); }
        if (map) {
#pragma unroll
            for (int r = 0; r < 16; r += 2) { const float ia = wsf[crow(r, hi)], ib = wsf[crow(r + 1, hi)];
#pragma unroll
                for (int d0 = 0; d0 < 4; ++d0) xw[(d0 * 8 + (r >> 1)) * 64 + lane] = pg8::cvt_pk_bf16(o[d0][r] * ia, o[d0][r + 1] * ib); }
        }
        __syncthreads();
        if (!map) {
            f32x16 a[4];
#pragma unroll
            for (int r = 0; r < 16; r += 2) { const float ia = wsf[crow(r, hi)], ib = wsf[crow(r + 1, hi)]; float sa = 0.f, sb = 0.f;
#pragma unroll
                for (int d0 = 0; d0 < 4; ++d0) { const unsigned w = xw[(d0 * 8 + (r >> 1)) * 64 + lane]; const float va = o[d0][r] * ia - bflo(w), vb = o[d0][r + 1] * ib - bfhi(w); a[d0][r] = va; a[d0][r + 1] = vb; sa += va * va; sb += vb * vb; }
                sa += __shfl_xor(sa, 1); sb += __shfl_xor(sb, 1); sa += __shfl_xor(sa, 2); sb += __shfl_xor(sb, 2); sa += __shfl_xor(sa, 4); sb += __shfl_xor(sb, 4); sa += __shfl_xor(sa, 8); sb += __shfl_xor(sb, 8); sa += __shfl_xor(sa, 16); sb += __shfl_xor(sb, 16);
                const float ra = 1.0f / sqrtf(sa * (1.f / 128.f) + EPS), rb = 1.0f / sqrtf(sb * (1.f / 128.f) + EPS);
#pragma unroll
                for (int d0 = 0; d0 < 4; ++d0) { a[d0][r] *= ra * gs[d0]; a[d0][r + 1] *= rb * gs[d0]; } }
            LAS bf16* stg = (LAS bf16*)xw;
            LDS_WAIT();
#pragma unroll
            for (int r = 0; r < 16; ++r)
#pragma unroll
                for (int d0 = 0; d0 < 4; ++d0) stg[crow(r, hi) * 128 + 32 * d0 + r32] = (bf16)f2bf(a[d0][r]);
            LDS_WAIT();
            bf16* Ow = p_Q(F) + (rowbase + q0 + wq * 32) * D + h * 128;
#pragma unroll
            for (int i = 0; i < 8; ++i) { const int row = i * 4 + (lane >> 4), ch = lane & 15; *(GAS v4u*)(Ow + (size_t)row * D + ch * 8) = *(const LAS v4u*)(stg + row * 128 + ch * 8); }
        }
    }
}
struct GmlpRegs { v4u raw[4]; float s1[4], s2[4]; unsigned uu[16]; };
__device__ __forceinline__ void gmlp_load(Frame& F, int unit, GmlpRegs& R) {
    const int tid = F.tid, lane = F.lane, r32 = lane & 31, hi = lane >> 5, wid = F.wave;
    const int b = unit >> 7, nc = (unit >> 3) & 15, g = unit & 7;
    const size_t t0 = (size_t)b * SEQ + 128 * nc; const int c0 = 128 * g;
    const int s_ = tid >> 4, ch = tid & 15, tb = wid >> 1, cbb = 2 * (wid & 1);
#pragma unroll
    for (int i = 0; i < 4; ++i) { const int s = s_ + 32 * i; R.raw[i] = *(const GAS v4u*)(p_GV(F) + (t0 + s) * D + c0 + ch * 8); R.s1[i] = p_GVSTAT(F)[2 * (t0 + s)]; R.s2[i] = p_GVSTAT(F)[2 * (t0 + s) + 1]; }
    const bf16* ub = p_U(F) + (t0 + 32 * tb) * D + c0 + 32 * cbb + r32;
#pragma unroll
    for (int r = 0; r < 16; ++r) { const int tl = crow(r, hi); R.uu[r] = (unsigned)ub[(size_t)tl * D] | ((unsigned)ub[(size_t)tl * D + 32] << 16); }
}
__device__ __forceinline__ void gmlp_compute(Frame& F, int unit, const GmlpRegs& R) {
    const int tid = F.tid, lane = F.lane, r32 = lane & 31, hi = lane >> 5, wid = F.wave;
    LAS unsigned char* lds = F.lds;
    const int b = unit >> 7, nc = (unit >> 3) & 15, g = unit & 7;
    const size_t t0 = (size_t)b * SEQ + 128 * nc; const int c0 = 128 * g;
    const int s_ = tid >> 4, ch = tid & 15, tb = wid >> 1, cbb = 2 * (wid & 1);
    const f32x4 lg0 = *(const GAS f32x4*)(p_ln_g(F) + c0 + ch * 8), lg1 = *(const GAS f32x4*)(p_ln_g(F) + c0 + ch * 8 + 4), lb0 = *(const GAS f32x4*)(p_ln_b(F) + c0 + ch * 8), lb1 = *(const GAS f32x4*)(p_ln_b(F) + c0 + ch * 8 + 4);
    const bf16* Wr = p_WSP(F) + ((size_t)g * 128 + 32 * tb + r32) * 128 + 4 * hi;
    v2u alo[8], ahi[8];
#pragma unroll
    for (int ks = 0; ks < 8; ++ks) { alo[ks] = *(const GAS v2u*)(Wr + 16 * ks); ahi[ks] = *(const GAS v2u*)(Wr + 16 * ks + 8); }
    float bs[16];
#pragma unroll
    for (int r = 0; r < 16; ++r) bs[r] = p_b_sp(F)[g * 128 + 32 * tb + crow(r, hi)];
    __syncthreads();
#if !(defined(ABLG) && ABLG == 3)
    { const float lgv[8] = {lg0.x, lg0.y, lg0.z, lg0.w, lg1.x, lg1.y, lg1.z, lg1.w}, lbv[8] = {lb0.x, lb0.y, lb0.z, lb0.w, lb1.x, lb1.y, lb1.z, lb1.w};
#pragma unroll
      for (int i = 0; i < 4; ++i) { const int s = s_ + 32 * i;
          const float mean = R.s1[i] * (1.f / D); const float rstd = 1.0f / sqrtf(fmaxf(R.s2[i] * (1.f / D) - mean * mean, 0.f) + EPS);
          const float x[8] = {bflo(R.raw[i].x), bfhi(R.raw[i].x), bflo(R.raw[i].y), bfhi(R.raw[i].y), bflo(R.raw[i].z), bfhi(R.raw[i].z), bflo(R.raw[i].w), bfhi(R.raw[i].w)};
          float y[8];
#pragma unroll
          for (int e = 0; e < 8; ++e) y[e] = (x[e] - mean) * rstd * lgv[e] + lbv[e];
          v4u o; o.x = pk2(y[0], y[1]); o.y = pk2(y[2], y[3]); o.z = pk2(y[4], y[5]); o.w = pk2(y[6], y[7]);
          *(LAS v4u*)(lds + (s >> 6) * 16384 + (ch >> 2) * 4096 + ((s & 63) >> 4) * 1024 + (s & 15) * 64 + (ch & 3) * 16) = o; } }
#endif
    __syncthreads();
    f32x16 acc0 = f32x16{}, acc1 = f32x16{};
    const LAS unsigned char* vp = lds + ((lane >> 4) & 1) * 32 + (lane & 3) * 8 + (4 * hi + ((lane & 15) >> 2)) * 64;
#pragma unroll
    for (int ks = 0; ks < 8; ++ks) {
#if defined(ABLG) && ABLG == 4
        if (ks < 0) {
#else
        if (ks < 2 * (tb + 1)) {
#endif
            const bf16x8 af = __builtin_bit_cast(bf16x8, (v4u){alo[ks].x, alo[ks].y, ahi[ks].x, ahi[ks].y});
            const LAS unsigned char* vt = vp + (ks >> 2) * 16384 + (ks & 3) * 1024 + cbb * 4096;
            const s16x4 l0 = vtr(vt), h0 = vtr(vt + 512), l1 = vtr(vt + 4096), h1 = vtr(vt + 4096 + 512);
            acc0 = __builtin_amdgcn_mfma_f32_32x32x16_bf16(af, (bf16x8){l0[0], l0[1], l0[2], l0[3], h0[0], h0[1], h0[2], h0[3]}, acc0, 0, 0, 0);
            acc1 = __builtin_amdgcn_mfma_f32_32x32x16_bf16(af, (bf16x8){l1[0], l1[1], l1[2], l1[3], h1[0], h1[1], h1[2], h1[3]}, acc1, 0, 0, 0);
        }
    }
    bf16* ub = p_U(F) + (t0 + 32 * tb) * D + c0 + 32 * cbb + r32;
#pragma unroll
    for (int r = 0; r < 16; ++r) { const int tl = crow(r, hi);
        ub[(size_t)tl * D] = (bf16)f2bf((acc0[r] + bs[r]) * bflo(R.uu[r])); ub[(size_t)tl * D + 32] = (bf16)f2bf((acc1[r] + bs[r]) * bfhi(R.uu[r])); }
}
__device__ __forceinline__ void gmlp_units(Frame& F, int first, int stride) {
    if (first >= 1024) return;
    GmlpRegs A, B; gmlp_load(F, first, A);
#pragma unroll 1
    for (int i = first; i < 1024; i += 2 * stride) {
        const bool m1 = i + stride < 1024, m2 = i + 2 * stride < 1024;
        if (m1) gmlp_load(F, i + stride, B);
        gmlp_compute(F, i, A);
        if (!m1) break;
        if (m2) gmlp_load(F, i + 2 * stride, A);
        gmlp_compute(F, i + stride, B);
    }
}

__global__ void __launch_bounds__(NWAVES * 64, 2) mk_fwd(Args args) {
    extern __shared__ __attribute__((aligned(16))) unsigned char lds[];
    Frame F;
    F.lds = (LAS unsigned char*)lds;
    F.MISC = (volatile LAS unsigned*)(F.lds + MISC_OFF);
    F.tid = threadIdx.x; F.lane = F.tid & 63; F.wave = __builtin_amdgcn_readfirstlane(F.tid >> 6);
    F.G = gridDim.x; { const int bx = blockIdx.x; F.vcu = (F.G % 8 == 0) ? (bx % 8) * (F.G / 8) + bx / 8 : bx; }
    unsigned char* ws = args.ws;
    F.ctl = (gu32*)(ws + WS_CTL);
    F.a = &args; F.ws = ws; F.out = args.out;
    for (int u = F.tid; u < (LDS_BYTES - LDSCTL_OFF) / 4; u += NWAVES * 64) ((LAS unsigned*)(F.lds + LDSCTL_OFF))[u] = 0u;
    __syncthreads();
    XcdBarrier bar; bar.bar = (unsigned*)(F.ctl + CW_BAR); bar.x = 0; bar.st = nullptr;
    if (N_LAUNCHES == 1) bar = xcd_barrier_post((unsigned*)(F.ctl + CW_BAR), F.MISC + 8);
#define GRID_BAR() do { if (N_LAUNCHES == 1) xcd_barrier(bar); } while (0)
    const int lo = args.ph_lo, hi = args.ph_hi;
#ifndef PH_MASK
#define PH_MASK 0xFFFF
#endif
#define IN(k) (((PH_MASK >> (k)) & 1) && lo <= (k) && (k) < hi)
#define BOTH(k) (IN(k) && IN((k) + 1))
#ifndef REPEAT_MASK
#define REPEAT_MASK 0
#endif
#define REPX(k)
#define PHASE_REFRESH() do { int t_ = threadIdx.x; asm volatile("" : "+v"(t_)); F.tid = t_; F.lane = t_ & 63; F.wave = __builtin_amdgcn_readfirstlane(t_ >> 6); } while (0)
    typedef pg8::StaticOrder SO;
#if defined(TSTAMP_A)
#define STAMP(k) do { if (blockIdx.x == 0 && F.tid == 0) ((unsigned long long*)(F.ws + WS_CTL + 40000))[k] = __builtin_amdgcn_s_memrealtime(); } while (0)
#else
#define STAMP(k) do { } while (0)
#endif
    STAMP(0);
    REPX(0) if (IN(0)) { PHASE_REFRESH(); p0_prologue(F); if (BOTH(0)) GRID_BAR(); STAMP(1); }
    REPX(1) if (IN(1)) { PHASE_REFRESH(); norm_rows(F, p_x(F), 0); if (BOTH(1)) GRID_BAR(); STAMP(2); }
    REPX(2) if (IN(2)) { PHASE_REFRESH(); pg8::Gemm g{p_XN(F), p_WGU1(F), M, NGU, D}; SO S; S.init(M, NGU, F.G, (int)blockIdx.x); pg8::EpiSwiGLU E{p_H(F), FF};
        pg8::gemm_phase<pg8::EpiSwiGLU, SO, PG8_ALIGN, PG8_SP2>(F.lds + RING_OFF, g, S, E);
        { const int nfull = (M / 256) * (NGU / 256) % F.G; if (nfull != 0) { if ((int)blockIdx.x >= nfull) p2_tail_convert(F, nfull); } else if (F.G > 0) p2_tail_convert(F, 0); }
        if (BOTH(2)) GRID_BAR(); STAMP(3); }
    REPX(3) if (IN(3)) { PHASE_REFRESH(); pg8::Gemm g{p_H(F), p_WD1(F), M, D, FF}; SO S; S.init(M, D, F.G, (int)blockIdx.x); pg8::EpiResGate<false, true, 2> E{p_x(F), p_X1B(F), p_MOD(F)};
        pg8::gemm_phase<pg8::EpiResGate<false, true, 2>, SO, PG8_ALIGN, PG8_SP2>(F.lds + RING_OFF, g, S, E); if (BOTH(3)) GRID_BAR(); STAMP(4); }
    REPX(4) if (IN(4)) { PHASE_REFRESH(); norm_rows_b16<NR4>(F, p_X1B(F), 1); if (BOTH(4)) GRID_BAR(); STAMP(5); }
    REPX(5) if (IN(5)) { PHASE_REFRESH(); pg8::Gemm g{p_XN(F), p_WINA(F), M, NINA, D}; SO S; S.init(M, NINA, F.G, (int)blockIdx.x); pg8::EpiInA E{p_Q(F), p_K(F), p_V(F), p_U(F), p_GV(F), p_q_g(F), p_k_g(F), p_GVSTAT(F), QSCALE};
        pg8::gemm_phase<pg8::EpiInA, SO, PG8_ALIGN, PG8_SP2>(F.lds + RING_OFF, g, S, E); if (BOTH(5)) GRID_BAR(); STAMP(6); }
    REPX(7) if (IN(7)) { PHASE_REFRESH();
#if defined(TQ)
        const unsigned long long tq0 = __builtin_amdgcn_s_memrealtime();
#endif
        for (int p = F.vcu; p < 256; p += F.G) { const int bh = p >> 2; attn_units(F, bh >> 3, bh & 7, p & 3); }
#if defined(TQ)
        __syncthreads(); const unsigned long long tq1 = __builtin_amdgcn_s_memrealtime();
#endif
        gmlp_units(F, F.vcu, F.G);
        __syncthreads();
#if defined(TQ)
        { const unsigned long long tq2 = __builtin_amdgcn_s_memrealtime(); if (blockIdx.x == TQ_BLOCK && F.tid == 0) { unsigned long long* ts = (unsigned long long*)(F.ws + WS_CTL + 40000); ts[20] = tq1 - tq0; ts[21] = tq2 - tq1; } }
#endif
        if (BOTH(7)) GRID_BAR(); STAMP(8); }
    REPX(8) if (IN(8)) { PHASE_REFRESH(); pg8::Gemm g{p_XN(F), p_WING(F), M, NING, D}; pg8::GateOrder S; S.init(M, D, F.G, (int)blockIdx.x); pg8::EpiGate E{p_K(F), p_V(F)};
        pg8::gemm_phase<pg8::EpiGate, pg8::GateOrder, PG8_ALIGN, PG8_SP2>(F.lds + RING_OFF, g, S, E); STAMP(9); }
    REPX(9) if (IN(9)) { PHASE_REFRESH(); SO S; S.init(M, D, F.G, (int)blockIdx.x);
        { pg8::Gemm g{p_Q(F), p_WA(F), M, D, D}; pg8::EpiProj<false> E{p_K(F), p_GV(F), (SKIP_MASK & 8) ? 0.f : 1.f}; pg8::gemm_phase<pg8::EpiProj<false>, SO, PG8_ALIGN, PG8_SP2>(F.lds + RING_OFF, g, S, E); }
        { pg8::Gemm g{p_U(F), p_WB(F), M, D, D}; pg8::EpiProj<true> E{p_V(F), p_GV(F), (SKIP_MASK & 16) ? 0.f : 1.f}; pg8::gemm_phase<pg8::EpiProj<true>, SO, PG8_ALIGN, PG8_SP2>(F.lds + RING_OFF, g, S, E); }
        if (BOTH(9)) GRID_BAR(); STAMP(10); }
    REPX(10) if (IN(10)) { PHASE_REFRESH(); pg8::Gemm g{p_GV(F), p_WO(F), M, D, D}; SO S; S.init(M, D, F.G, (int)blockIdx.x); pg8::EpiResGate<true, true, 5> E{p_X1B(F), p_X2B(F), p_MOD(F)};
        pg8::gemm_phase<pg8::EpiResGate<true, true, 5>, SO, PG8_ALIGN, PG8_SP2>(F.lds + RING_OFF, g, S, E); if (BOTH(10)) GRID_BAR(); STAMP(11); }
    REPX(11) if (IN(11)) { PHASE_REFRESH(); norm_rows_b16<NR11>(F, p_X2B(F), 2); if (BOTH(11)) GRID_BAR(); STAMP(12); }
    REPX(12) if (IN(12)) { PHASE_REFRESH(); pg8::Gemm g{p_XN(F), p_WGU2(F), M, NGU, D}; SO S; S.init(M, NGU, F.G, (int)blockIdx.x); pg8::EpiSwiGLU E{p_H(F), FF};
        pg8::gemm_phase<pg8::EpiSwiGLU, SO, PG8_ALIGN, PG8_SP2>(F.lds + RING_OFF, g, S, E);
        { const int nfull = (M / 256) * (NGU / 256) % F.G; if (nfull != 0) { if ((int)blockIdx.x >= nfull) p12_tail_convert(F, nfull); } else p12_tail_convert(F, 0); }
        if (BOTH(12)) GRID_BAR(); STAMP(13); }
    REPX(13) if (IN(13)) { PHASE_REFRESH(); pg8::Gemm g{p_H(F), p_WD2(F), M, D, FF}; SO S; S.init(M, D, F.G, (int)blockIdx.x); pg8::EpiResGate<true, false, 8> E{p_X2B(F), F.out, p_MOD(F)};
        pg8::gemm_phase<pg8::EpiResGate<true, false, 8>, SO, PG8_ALIGN, PG8_SP2>(F.lds + RING_OFF, g, S, E); }
#if defined(TQ)
    GRID_BAR();
    for (size_t i_ = (size_t)blockIdx.x * 512 + F.tid; i_ < (size_t)M * D; i_ += (size_t)F.G * 512) F.out[i_] = 0.f;
    GRID_BAR();
    if (blockIdx.x == 0 && F.tid == 0) { const unsigned long long* ts = (const unsigned long long*)(F.ws + WS_CTL + 40000); const float us = (float)ts[20 + TQ] * 0.01f; int c = 0;
        for (int i = 0; i < 6; ++i) c += us > (TQ_T0 + i * TQ_DT) ? 1 : 0; F.out[0] = 1000.f * (float)(c + 1); }
#endif
#if defined(EXTRA_BARS)
    for (int i_ = 0; i_ < EXTRA_BARS; ++i_) GRID_BAR();
#endif
#if defined(TSTAMP_A)
    GRID_BAR();
    if (blockIdx.x == 0 && F.tid == 0) { const unsigned long long* ts = (const unsigned long long*)(F.ws + WS_CTL + 40000); F.out[0] = (float)(ts[TSTAMP_B] - ts[TSTAMP_A]); }
#endif
#undef IN
#undef BOTH
}

extern "C" void kernel_launch(void* const* d_in, const int* in_sizes, int n_in, void* d_out, int out_size, void* d_ws, size_t ws_size, hipStream_t stream) {
    static int grid = 0;
    if (grid == 0) {
        if (n_in != 26 || in_sizes[0] != M * D || out_size != M * D || ws_size < WS_END) { fprintf(stderr, "kernel_launch: unexpected problem (n_in %d, in0 %d, out %d, ws %zu)\n", n_in, n_in > 0 ? in_sizes[0] : -1, out_size, ws_size); grid = -1; return; }
        int dev = 0, cus = 0;
        if (hipGetDevice(&dev) != hipSuccess || hipDeviceGetAttribute(&cus, hipDeviceAttributeMultiprocessorCount, dev) != hipSuccess) { grid = -1; return; }
        if (hipFuncSetAttribute((const void*)mk_fwd, hipFuncAttributeMaxDynamicSharedMemorySize, LDS_BYTES) != hipSuccess) { fprintf(stderr, "kernel_launch: hipFuncSetAttribute failed\n"); grid = -1; return; }
        int per_cu = 0;
        if (hipOccupancyMaxActiveBlocksPerMultiprocessor(&per_cu, (const void*)mk_fwd, NWAVES * 64, LDS_BYTES) != hipSuccess || per_cu < 1) fprintf(stderr, "kernel_launch: occupancy query says %d\n", per_cu);
        (void)hipGetLastError();
        grid = cus;
    }
    if (grid < 0) return;
    if (hipMemsetAsync((char*)d_ws + WS_CTL, 0, CTL_ZERO_BYTES, stream) != hipSuccess) return;
    Args a{};
    for (int i = 0; i < 26; ++i) a.in[i] = (const float*)d_in[i];
    a.out = (float*)d_out; a.ws = (unsigned char*)d_ws;
    for (int li = 0; li < N_LAUNCHES; ++li) {
        a.ph_lo = (N_LAUNCHES == 1) ? 0 : li; a.ph_hi = (N_LAUNCHES == 1) ? N_PHASES : li + 1; a.li = li;
        hipLaunchKernelGGL(mk_fwd, dim3(grid), dim3(NWAVES * 64), LDS_BYTES, stream, a);
    }
}
```

```cpp
#include <hip/hip_runtime.h>
#include <cstdio>
#include <cstdint>
namespace pg8 {
#define PG8_LAS __attribute__((address_space(3)))
typedef unsigned short bf16_t;
typedef short bf16x8 __attribute__((ext_vector_type(8)));
typedef float f32x4 __attribute__((ext_vector_type(4)));
typedef unsigned u32x4 __attribute__((ext_vector_type(4)));
constexpr int BM = 256, BK = 64, HALF = 128, HTB = HALF * BK * 2  , STAGE_BYTES = 8 * HTB, NXCD = 8, WGM = 8;

__host__ __device__ __forceinline__ int lds_byte(int r, int c) { const int st = (r >> 4) * 2 + (c >> 5), rr = r & 15, cc = c & 31, ob = rr * 64 + cc * 2; return st * 1024 + (ob ^ (((ob >> 9) & 1) << 5)); }
__host__ __device__ __forceinline__ void stage_rc(int b, int& R, int& C) { const int st = b / 1024, sb = b % 1024, swz = sb ^ (((sb >> 9) & 1) << 5); R = (st >> 1) * 16 + swz / 64; C = (st & 1) * 32 + (swz % 64) / 2; }
__host__ __device__ __forceinline__ int perm32(int rho) { const int n = rho >> 4, i = rho & 15; return 8 * (i >> 2) + 4 * n + (i & 3); }

struct Unit { int pm, pn; };
struct Gemm { const bf16_t* A; const bf16_t* Bt; int M, N, K; };

struct StaticOrder {
    int nM, nN, nwg, G, c;
    __host__ __device__ void init(int M, int N, int G_, int c_) { nM = M / BM; nN = N / BM; nwg = nM * nN; G = G_; c = c_; }
    __host__ __device__ bool next(int i, Unit& u) const {
        const long L = (long)i * G + c; if (L >= nwg) return false;
        int wgid = (int)L; { const int q = nwg / NXCD, r = nwg % NXCD, xcd = wgid % NXCD, off = wgid / NXCD; wgid = (xcd < r ? xcd * (q + 1) : r * (q + 1) + (xcd - r) * q) + off; }
        const int nig = WGM * nN, gid = wgid / nig, fm = gid * WGM, gsz = (nM - fm) < WGM ? (nM - fm) : WGM;
        u.pm = fm + ((wgid % nig) % gsz); u.pn = (wgid % nig) / gsz; return true;
    }
    __device__ __forceinline__ void a_ready(const Unit&) const {}
    __device__ __forceinline__ void done(const Unit&) const {}
};

struct GateOrder {
    StaticOrder so;
    __host__ __device__ void init(int M, int N, int G_, int c_) { so.init(M, N, G_, c_); }
    __host__ __device__ bool next(int i, Unit& u) const { if (!so.next(i >> 1, u)) return false; u.pn += (i & 1) * so.nN; return true; }
    __device__ __forceinline__ void a_ready(const Unit&) const {}
    __device__ __forceinline__ void done(const Unit&) const {}
};

typedef float cvt_f32x2_t __attribute__((ext_vector_type(2))); typedef __bf16 cvt_bf16x2_t __attribute__((ext_vector_type(2)));
__device__ __forceinline__ unsigned cvt_pk_bf16(float lo, float hi) { cvt_f32x2_t v = {lo, hi}; cvt_bf16x2_t b = __builtin_convertvector(v, cvt_bf16x2_t); return __builtin_bit_cast(unsigned, b); }
typedef float f32x2 __attribute__((ext_vector_type(2)));
__device__ __forceinline__ f32x2 gelu_pk(f32x2 v) {
    const f32x2 av = __builtin_elementwise_abs(v), d = av * 0.2316418882f + 1.0f;
    f32x2 t; t.x = __builtin_amdgcn_rcpf(d.x); t.y = __builtin_amdgcn_rcpf(d.y);
    f32x2 q = t * 0.5307027145f + (-0.7265760135f); q = q * t + 0.7107068705f; q = q * t + (-0.142248368f); q = q * t + 0.127414796f; q = q * t;
    const f32x2 s = (v * v) * (-0.72134752044f);
    f32x2 e; e.x = __builtin_amdgcn_exp2f(s.x); e.y = __builtin_amdgcn_exp2f(s.y);
    const f32x2 m = v * (q * e), r = v - m;
    f32x2 o; o.x = v.x < 0.f ? m.x : r.x; o.y = v.y < 0.f ? m.y : r.y; return o;
}

__device__ __forceinline__ float bf2f(unsigned short h) { return __uint_as_float((unsigned)h << 16); }
__device__ __forceinline__ float bflo(unsigned w) { return __uint_as_float(w << 16); }
__device__ __forceinline__ float bfhi(unsigned w) { return __uint_as_float(w & 0xffff0000u); }
__device__ __forceinline__ float sigmoidf_fast(float x) { return __builtin_amdgcn_rcpf(1.0f + __builtin_amdgcn_exp2f(-1.4426950408889634f * x)); }
__device__ __forceinline__ u32x4 pack8(const f32x4& v0, const f32x4& v1) { u32x4 w; w.x = cvt_pk_bf16(v0[0], v0[1]); w.y = cvt_pk_bf16(v0[2], v0[3]); w.z = cvt_pk_bf16(v1[0], v1[1]); w.w = cvt_pk_bf16(v1[2], v1[3]); return w; }

struct EpiSwiGLU {
    static constexpr bool PERM = true, AFTER_DRAIN = false;
    bf16_t* H; int ldh;
    __device__ __forceinline__ void operator()(const f32x4 (&acc)[2][2][4][2], const Unit& u, int wr, int wc, int fr, int fq) const {
        const int row0 = u.pm * BM + wr * 64 + fr, col0 = u.pn * HALF + wc * 32 + 8 * fq;
#pragma unroll
        for (int ai = 0; ai < 2; ++ai)
#pragma unroll
            for (int m = 0; m < 4; ++m) { bf16_t* rowp = H + (size_t)(row0 + ai * HALF + m * 16) * ldh + col0;
                f32x4 h0, h1;
#pragma unroll
                for (int j = 0; j < 4; ++j) { const float g0 = acc[ai][0][m][0][j], g1 = acc[ai][0][m][1][j];
                    h0[j] = g0 * sigmoidf_fast(g0) * acc[ai][1][m][0][j]; h1[j] = g1 * sigmoidf_fast(g1) * acc[ai][1][m][1][j]; }
                *(u32x4*)rowp = pack8(h0, h1); }
    }
};
template <bool BASE_BF16, bool OUT_BF16, int gidx> struct EpiResGate {
    static constexpr bool PERM = true, AFTER_DRAIN = false;
    static constexpr float coef = gidx == 5 ? 1.0f : 0.5f;
    const void* base; void* out; const float* mod;
    __device__ __forceinline__ void ldb(f32x4& a, f32x4& b, size_t off) const {
        if (BASE_BF16) { const u32x4 w = *(const u32x4*)((const bf16_t*)base + off); a = (f32x4){bflo(w.x), bfhi(w.x), bflo(w.y), bfhi(w.y)}; b = (f32x4){bflo(w.z), bfhi(w.z), bflo(w.w), bfhi(w.w)}; }
        else { a = *(const f32x4*)((const float*)base + off); b = *(const f32x4*)((const float*)base + off + 4); }
    }
    __device__ __forceinline__ void operator()(const f32x4 (&acc)[2][2][4][2], const Unit& u, int wr, int wc, int fr, int fq) const {
        const int row0 = u.pm * BM + wr * 64 + fr, col0 = u.pn * BM + wc * 32 + 8 * fq;
        const float* gate = mod + (size_t)(u.pm >> 3) * 9216 + gidx * 1024 + col0;
        f32x4 gv[2][2];
#pragma unroll
        for (int bj = 0; bj < 2; ++bj)
#pragma unroll
            for (int n = 0; n < 2; ++n) gv[bj][n] = *(const f32x4*)(gate + bj * HALF + n * 4) * coef;
        f32x4 nb[2][2];
#pragma unroll
        for (int bj = 0; bj < 2; ++bj) ldb(nb[bj][0], nb[bj][1], (size_t)row0 * 1024 + col0 + bj * HALF);
#pragma unroll
        for (int g = 0; g < 8; ++g) { const int ai = g >> 2, m = g & 3; const size_t off = (size_t)(row0 + ai * HALF + m * 16) * 1024 + col0;
            f32x4 cb[2][2];
#pragma unroll
            for (int bj = 0; bj < 2; ++bj) { cb[bj][0] = nb[bj][0]; cb[bj][1] = nb[bj][1]; }
            if (g < 7) { const size_t off2 = (size_t)(row0 + ((g + 1) >> 2) * HALF + ((g + 1) & 3) * 16) * 1024 + col0;
#pragma unroll
                for (int bj = 0; bj < 2; ++bj) ldb(nb[bj][0], nb[bj][1], off2 + bj * HALF); }
#pragma unroll
            for (int bj = 0; bj < 2; ++bj) { const f32x4 x0 = cb[bj][0] + gv[bj][0] * acc[ai][bj][m][0], x1 = cb[bj][1] + gv[bj][1] * acc[ai][bj][m][1];
                if (OUT_BF16) *(u32x4*)((bf16_t*)out + off + bj * HALF) = pack8(x0, x1);
                else { *(f32x4*)((float*)out + off + bj * HALF) = x0; *(f32x4*)((float*)out + off + bj * HALF + 4) = x1; } }
            asm volatile("" ::: "memory"); }
    }
};
struct EpiInA {
    static constexpr bool PERM = true, AFTER_DRAIN = false;
    bf16_t *Q, *K, *V, *U, *GV; const float *qg, *kg; float* gvstat; float qscale;
    __device__ __forceinline__ void operator()(const f32x4 (&acc)[2][2][4][2], const Unit& u, int wr, int wc, int fr, int fq) const {
        const int row0 = u.pm * BM + wr * 64 + fr, ty = u.pn >> 2, pq = u.pn & 3;
        bf16_t* base = ty == 0 ? Q : ty == 1 ? K : ty == 2 ? V : ty == 3 ? U : GV;
        if (ty < 2) {
            const float* gp = (ty ? kg : qg) + 8 * fq; const float gsc = ty ? 1.0f : qscale;
            f32x4 gn[2][2];
#pragma unroll
            for (int bj = 0; bj < 2; ++bj)
#pragma unroll
                for (int n = 0; n < 2; ++n) gn[bj][n] = *(const f32x4*)(gp + 32 * bj + 4 * n) * gsc;
#pragma unroll
            for (int ai = 0; ai < 2; ++ai)
#pragma unroll
                for (int m = 0; m < 4; ++m) { bf16_t* rowp = base + (size_t)(row0 + ai * HALF + m * 16) * 1024 + pq * BM + 64 * wc + 8 * fq;
                    float ss = 0.f;
#pragma unroll
                    for (int bj = 0; bj < 2; ++bj)
#pragma unroll
                        for (int n = 0; n < 2; ++n) { const f32x4 x = acc[ai][bj][m][n]; ss += (x[0] * x[0] + x[1] * x[1]) + (x[2] * x[2] + x[3] * x[3]); }
                    ss += __shfl_xor(ss, 16); ss += __shfl_xor(ss, 32);
                    const float rstd = 1.0f / sqrtf(ss * (1.0f / 64.0f) + 1e-6f);
#pragma unroll
                    for (int bj = 0; bj < 2; ++bj) *(u32x4*)(rowp + 32 * bj) = pack8(acc[ai][bj][m][0] * rstd * gn[bj][0], acc[ai][bj][m][1] * rstd * gn[bj][1]); }
            return;
        }
        const bool act = ty >= 3, st = ty == 4;
#pragma unroll
        for (int ai = 0; ai < 2; ++ai)
#pragma unroll
            for (int m = 0; m < 4; ++m) { const int row = row0 + ai * HALF + m * 16; bf16_t* rowp = base + (size_t)row * 1024 + pq * BM + 32 * wc + 8 * fq;
                float s1 = 0.f, s2 = 0.f;
#pragma unroll
                for (int bj = 0; bj < 2; ++bj) { f32x4 v0 = acc[ai][bj][m][0], v1 = acc[ai][bj][m][1];
                    if (act) { f32x2 a = gelu_pk((f32x2){v0[0], v0[1]}), b = gelu_pk((f32x2){v0[2], v0[3]}), c = gelu_pk((f32x2){v1[0], v1[1]}), d = gelu_pk((f32x2){v1[2], v1[3]});
                        v0 = (f32x4){a.x, a.y, b.x, b.y}; v1 = (f32x4){c.x, c.y, d.x, d.y}; }
                    s1 += (v0[0] + v0[1]) + (v0[2] + v0[3]) + (v1[0] + v1[1]) + (v1[2] + v1[3]);
                    s2 += (v0[0] * v0[0] + v0[1] * v0[1]) + (v0[2] * v0[2] + v0[3] * v0[3]) + (v1[0] * v1[0] + v1[1] * v1[1]) + (v1[2] * v1[2] + v1[3] * v1[3]);
                    *(u32x4*)(rowp + HALF * bj) = pack8(v0, v1); }
                if (st) { s1 += __shfl_xor(s1, 16); s1 += __shfl_xor(s1, 32); s2 += __shfl_xor(s2, 16); s2 += __shfl_xor(s2, 32);
                    if (fq == 0) { atomicAdd(gvstat + 2 * (size_t)row, s1); atomicAdd(gvstat + 2 * (size_t)row + 1, s2); } } }
    }
};
struct EpiGate {
    static constexpr bool PERM = true, AFTER_DRAIN = false;
    bf16_t *GA, *GB;
    __device__ __forceinline__ void operator()(const f32x4 (&acc)[2][2][4][2], const Unit& u, int wr, int wc, int fr, int fq) const {
        const int row0 = u.pm * BM + wr * 64 + fr, pq = u.pn & 3;
        bf16_t* base = (u.pn >> 2) ? GB : GA;
#pragma unroll
        for (int ai = 0; ai < 2; ++ai)
#pragma unroll
            for (int m = 0; m < 4; ++m) { bf16_t* rowp = base + (size_t)(row0 + ai * HALF + m * 16) * 1024 + pq * BM + 32 * wc + 8 * fq;
#pragma unroll
                for (int bj = 0; bj < 2; ++bj) { f32x4 v0 = acc[ai][bj][m][0], v1 = acc[ai][bj][m][1];
#pragma unroll
                    for (int j = 0; j < 4; ++j) { v0[j] = sigmoidf_fast(v0[j]); v1[j] = sigmoidf_fast(v1[j]); }
                    *(u32x4*)(rowp + HALF * bj) = pack8(v0, v1); } }
    }
};
template <bool ADD> struct EpiProj {
    static constexpr bool PERM = true, AFTER_DRAIN = false;
    const bf16_t* G; bf16_t* MG;
    __device__ __forceinline__ void operator()(const f32x4 (&acc)[2][2][4][2], const Unit& u, int wr, int wc, int fr, int fq) const {
        const int row0 = u.pm * BM + wr * 64 + fr, col0 = u.pn * BM + 32 * wc + 8 * fq;
        u32x4 ng[2], np[2];
#pragma unroll
        for (int bj = 0; bj < 2; ++bj) { ng[bj] = *(const u32x4*)(G + (size_t)row0 * 1024 + col0 + HALF * bj); np[bj] = ADD ? *(const u32x4*)(MG + (size_t)row0 * 1024 + col0 + HALF * bj) : (u32x4){0u, 0u, 0u, 0u}; }
#pragma unroll
        for (int gi = 0; gi < 8; ++gi) { const int ai = gi >> 2, m = gi & 3; const size_t off = (size_t)(row0 + ai * HALF + m * 16) * 1024 + col0;
            u32x4 cg[2], cp[2];
#pragma unroll
            for (int bj = 0; bj < 2; ++bj) { cg[bj] = ng[bj]; cp[bj] = np[bj]; }
            if (gi < 7) { const size_t off2 = (size_t)(row0 + ((gi + 1) >> 2) * HALF + ((gi + 1) & 3) * 16) * 1024 + col0;
#pragma unroll
                for (int bj = 0; bj < 2; ++bj) { ng[bj] = *(const u32x4*)(G + off2 + HALF * bj); if (ADD) np[bj] = *(const u32x4*)(MG + off2 + HALF * bj); } }
#pragma unroll
            for (int bj = 0; bj < 2; ++bj) { const u32x4 g = cg[bj];
                f32x4 v0 = acc[ai][bj][m][0], v1 = acc[ai][bj][m][1];
                v0[0] *= bflo(g.x); v0[1] *= bfhi(g.x); v0[2] *= bflo(g.y); v0[3] *= bfhi(g.y); v1[0] *= bflo(g.z); v1[1] *= bfhi(g.z); v1[2] *= bflo(g.w); v1[3] *= bfhi(g.w);
                if (ADD) { const u32x4 p = cp[bj];
                    v0[0] += bflo(p.x); v0[1] += bfhi(p.x); v0[2] += bflo(p.y); v0[3] += bfhi(p.y); v1[0] += bflo(p.z); v1[1] += bfhi(p.z); v1[2] += bflo(p.w); v1[3] += bfhi(p.w); }
                *(u32x4*)(MG + off + HALF * bj) = pack8(v0, v1); }
            asm volatile("" ::: "memory"); }
    }
};

template <class Epi, class Sched, bool ALIGN_EPI = false, bool SP2 = false>
__device__ __forceinline__ void gemm_phase(PG8_LAS unsigned char* lds, const Gemm g, const Sched& S, const Epi& E) {
    int tid_ = threadIdx.x; asm volatile("" : "+v"(tid_));
    const int tid = tid_, wid = __builtin_amdgcn_readfirstlane(tid >> 6), lane = tid & 63, wr = wid >> 2, wc = wid & 3, fr = lane & 15, fq = lane >> 4;
    const int K = g.K, nt = K / BK;
    unsigned voffA[2], voffB[2];
#pragma unroll
    for (int i = 0; i < 2; ++i) { int R, C; stage_rc(tid * 16 + i * 8192, R, C); const int Rb = Epi::PERM ? ((R & ~31) + perm32(R & 31)) : R;
        voffA[i] = (unsigned)(R * K + C) * 2u; voffB[i] = (unsigned)(Rb * K + C) * 2u; }
    const size_t kstep = (size_t)(BK * 2);
    const size_t hstep = (size_t)HALF * K * 2;
    const size_t tstep = 2 * hstep;
    const unsigned ldsw = (unsigned)wid * 1024u;
    const int aoff = lds_byte(wr * 64 + fr, fq * 8), boff = lds_byte(wc * 32 + fr, fq * 8);
#define PG8_SA(b, h) (((b) * 2 + (h)) * HTB)
#define PG8_SB(b, h) ((4 + (b) * 2 + (h)) * HTB)
#define PG8_STAGE(bufoff, gbase, voff) do { _Pragma("unroll") for (int _i = 0; _i < 2; ++_i) \
        __builtin_amdgcn_global_load_lds((const unsigned*)((const char*)(gbase) + (voff)[_i]), (PG8_LAS unsigned*)(lds + (bufoff) + ldsw + _i * 8192), 16, 0, 0); } while (0)
#define PG8_LDA(dst, b, h) do { _Pragma("unroll") for (int m = 0; m < 4; ++m) _Pragma("unroll") for (int k = 0; k < 2; ++k) dst[m][k] = *(const PG8_LAS bf16x8*)(lds + PG8_SA(b, h) + aoff + m * 2048 + k * 1024); } while (0)
#define PG8_LDB(dst, b, h) do { _Pragma("unroll") for (int n = 0; n < 2; ++n) _Pragma("unroll") for (int k = 0; k < 2; ++k) dst[n][k] = *(const PG8_LAS bf16x8*)(lds + PG8_SB(b, h) + boff + n * 2048 + k * 1024); } while (0)
#define PG8_MMA(ai, bj, At, Bt) do { __builtin_amdgcn_s_setprio(1); _Pragma("unroll") for (int m = 0; m < 4; ++m) _Pragma("unroll") for (int n = 0; n < 2; ++n) _Pragma("unroll") for (int k = 0; k < 2; ++k) \
        acc[ai][bj][m][n] = __builtin_amdgcn_mfma_f32_16x16x32_bf16(Bt[n][k], At[m][k], acc[ai][bj][m][n], 0, 0, 0); __builtin_amdgcn_s_setprio(0); } while (0)
#define PG8_WAIT_V(n) asm volatile("s_waitcnt vmcnt(" #n ")" ::: "memory")
#define PG8_WAIT_L(n) asm volatile("s_waitcnt lgkmcnt(" #n ")" ::: "memory")
#define PG8_BAR __builtin_amdgcn_s_barrier()
#define PG8_SCHED __builtin_amdgcn_sched_barrier(0)
    Unit cur, nxt; int ui = 0;
    if (!S.next(0, cur)) return;
    f32x4 acc[2][2][4][2];
#pragma unroll
    for (int a = 0; a < 2; ++a)
#pragma unroll
        for (int b = 0; b < 2; ++b)
#pragma unroll
            for (int m = 0; m < 4; ++m)
#pragma unroll
                for (int n = 0; n < 2; ++n) acc[a][b][m][n] = (f32x4){0.f, 0.f, 0.f, 0.f};
    bf16x8 At[4][2], B0[2][2], B1[2][2];
    const char* cA = (const char*)g.A + (size_t)cur.pm * tstep; const char* cB = (const char*)g.Bt + (size_t)cur.pn * tstep;
    S.a_ready(cur);
    if constexpr (SP2) {
        PG8_STAGE(PG8_SB(0, 0), cB, voffB); PG8_STAGE(PG8_SB(0, 1), cB + hstep, voffB); PG8_STAGE(PG8_SA(0, 0), cA, voffA); PG8_STAGE(PG8_SA(0, 1), cA + hstep, voffA);
        if (wr == 1) PG8_BAR;
        PG8_WAIT_V(2); PG8_BAR;
        PG8_STAGE(PG8_SB(1, 0), cB + kstep, voffB); PG8_STAGE(PG8_SA(1, 0), cA + kstep, voffA); PG8_STAGE(PG8_SB(1, 1), cB + hstep + kstep, voffB);
        PG8_WAIT_V(6); PG8_BAR;
    } else {
        PG8_STAGE(PG8_SB(0, 0), cB, voffB); PG8_STAGE(PG8_SA(0, 0), cA, voffA); PG8_STAGE(PG8_SB(0, 1), cB + hstep, voffB); PG8_STAGE(PG8_SA(0, 1), cA + hstep, voffA);
        if (wr == 1) PG8_BAR;
        PG8_WAIT_V(4); PG8_BAR;
        PG8_STAGE(PG8_SB(1, 0), cB + kstep, voffB); PG8_STAGE(PG8_SA(1, 0), cA + kstep, voffA); PG8_STAGE(PG8_SB(1, 1), cB + hstep + kstep, voffB);
        PG8_WAIT_V(6); PG8_BAR;
    }
    for (;;) {
        const bool has_next = S.next(ui + 1, nxt);
        const char* nA = has_next ? (const char*)g.A + (size_t)nxt.pm * tstep : cA; const char* nB = has_next ? (const char*)g.Bt + (size_t)nxt.pn * tstep : cB;
        for (int t = 0; t < nt; t += 2) {
            const bool last = (t == nt - 2);
            const char* a1 = cA + (size_t)(t + 1) * kstep;
            const char* a2 = last ? nA : cA + (size_t)(t + 2) * kstep; const char* b2 = last ? nB : cB + (size_t)(t + 2) * kstep;
            const char* a3 = a2 + kstep; const char* b3 = b2 + kstep;
            if (last && has_next) S.a_ready(nxt);
            if constexpr (SP2) {
            PG8_LDB(B0, 0, 0); PG8_LDB(B1, 0, 1); PG8_SCHED; PG8_LDA(At, 0, 0); PG8_STAGE(PG8_SA(1, 1), a1 + hstep, voffA);
            PG8_WAIT_V(8); PG8_WAIT_L(0); PG8_BAR; PG8_MMA(0, 0, At, B0); PG8_MMA(0, 1, At, B1); PG8_BAR; PG8_SCHED;
            PG8_LDA(At, 0, 1); PG8_STAGE(PG8_SB(0, 0), b2, voffB); PG8_STAGE(PG8_SB(0, 1), b2 + hstep, voffB); PG8_STAGE(PG8_SA(0, 0), a2, voffA);
            PG8_WAIT_V(8); PG8_WAIT_L(0); PG8_BAR; PG8_MMA(1, 0, At, B0); PG8_MMA(1, 1, At, B1); PG8_BAR; PG8_SCHED;
            PG8_LDB(B0, 1, 0); PG8_LDB(B1, 1, 1); PG8_SCHED; PG8_LDA(At, 1, 0); PG8_STAGE(PG8_SA(0, 1), a2 + hstep, voffA);
            PG8_WAIT_V(8); PG8_WAIT_L(0); PG8_BAR; PG8_MMA(0, 0, At, B0); PG8_MMA(0, 1, At, B1); PG8_BAR; PG8_SCHED;
            PG8_LDA(At, 1, 1); PG8_STAGE(PG8_SB(1, 0), b3, voffB); PG8_STAGE(PG8_SB(1, 1), b3 + hstep, voffB); PG8_STAGE(PG8_SA(1, 0), a3, voffA);
            PG8_WAIT_V(8); PG8_WAIT_L(0); PG8_BAR; PG8_MMA(1, 0, At, B0); PG8_MMA(1, 1, At, B1); PG8_BAR; PG8_SCHED;
            } else {
            PG8_LDB(B0, 0, 0); PG8_SCHED; PG8_LDA(At, 0, 0); PG8_STAGE(PG8_SA(1, 1), a1 + hstep, voffA);
            PG8_WAIT_L(8); PG8_BAR; PG8_WAIT_L(0); PG8_MMA(0, 0, At, B0); PG8_BAR; PG8_SCHED;
            PG8_LDB(B1, 0, 1); PG8_STAGE(PG8_SB(0, 0), b2, voffB);
            PG8_BAR; PG8_WAIT_L(0); PG8_MMA(0, 1, At, B1); PG8_BAR;
            PG8_LDA(At, 0, 1); PG8_STAGE(PG8_SA(0, 0), a2, voffA);
            PG8_BAR; PG8_WAIT_L(0); PG8_MMA(1, 0, At, B0); PG8_BAR; PG8_SCHED;
            PG8_STAGE(PG8_SB(0, 1), b2 + hstep, voffB);
            PG8_WAIT_V(6); PG8_BAR; PG8_MMA(1, 1, At, B1); PG8_BAR;
            PG8_LDB(B0, 1, 0); PG8_SCHED; PG8_LDA(At, 1, 0); PG8_STAGE(PG8_SA(0, 1), a2 + hstep, voffA);
            PG8_WAIT_L(8); PG8_BAR; PG8_WAIT_L(0); PG8_MMA(0, 0, At, B0); PG8_BAR; PG8_SCHED;
            PG8_LDB(B1, 1, 1); PG8_STAGE(PG8_SB(1, 0), b3, voffB);
            PG8_BAR; PG8_WAIT_L(0); PG8_MMA(0, 1, At, B1); PG8_BAR;
            PG8_LDA(At, 1, 1); PG8_STAGE(PG8_SA(1, 0), a3, voffA);
            PG8_BAR; PG8_WAIT_L(0); PG8_MMA(1, 0, At, B0); PG8_BAR; PG8_SCHED;
            PG8_STAGE(PG8_SB(1, 1), b3 + hstep, voffB);
            PG8_WAIT_V(6); PG8_BAR; PG8_MMA(1, 1, At, B1); PG8_BAR;
            }
        }
        if constexpr (ALIGN_EPI) { if (wr == 0) PG8_BAR; }
        if constexpr (!Epi::AFTER_DRAIN) { E(acc, cur, wr, wc, fr, fq); S.done(cur); }
        if (!has_next) break;
#pragma unroll
        for (int a = 0; a < 2; ++a)
#pragma unroll
            for (int b = 0; b < 2; ++b)
#pragma unroll
                for (int m = 0; m < 4; ++m)
#pragma unroll
                    for (int n = 0; n < 2; ++n) acc[a][b][m][n] = (f32x4){0.f, 0.f, 0.f, 0.f};
        cur = nxt; cA = nA; cB = nB; ++ui;
        if constexpr (ALIGN_EPI) { if (wr == 1) PG8_BAR; }
    }
    PG8_WAIT_V(0);
    if constexpr (!ALIGN_EPI) { if (wr == 0) PG8_BAR; }
    PG8_BAR;
    if constexpr (Epi::AFTER_DRAIN) { E.fused(acc, cur, wr, wc, fr, fq, lds, wid, lane); S.done(cur); }
#undef PG8_SA
#undef PG8_SB
#undef PG8_STAGE
#undef PG8_LDA
#undef PG8_LDB
#undef PG8_MMA
#undef PG8_WAIT_V
#undef PG8_WAIT_L
#undef PG8_BAR
#undef PG8_SCHED
}
}

#ifndef PG8_SP2
#define PG8_SP2 true
#endif
#ifndef PG8_ALIGN
#define PG8_ALIGN true
#endif
#define GAS __attribute__((address_space(1)))
#define LAS __attribute__((address_space(3)))
typedef unsigned short bf16;
typedef unsigned v4u __attribute__((ext_vector_type(4)));
typedef float f32x4 __attribute__((ext_vector_type(4)));
typedef short bf16x8 __attribute__((ext_vector_type(8)));
typedef GAS unsigned gu32;
typedef GAS unsigned long long gu64;
#define RLX_AGENT __ATOMIC_RELAXED, __HIP_MEMORY_SCOPE_AGENT
#define LDS_WAIT() asm volatile("s_waitcnt lgkmcnt(0)" ::: "memory")
#define VM_WAIT() asm volatile("s_waitcnt vmcnt(0)" ::: "memory")
__device__ __forceinline__ unsigned long long rt() { return __builtin_amdgcn_s_memrealtime(); }
__device__ __forceinline__ unsigned f2bf(float f) { unsigned u = __builtin_bit_cast(unsigned, f); return (u + 0x7fffu + ((u >> 16) & 1u)) >> 16; }
__device__ __forceinline__ unsigned pk2(float lo, float hi) { return f2bf(lo) | (f2bf(hi) << 16); }

#define XB_TMO      128
#define XB_XCNT(j)  (256  + 64 * (j))
#define XB_XSUB(j)  (1280 + 64 * (j))
#define XB_XGEN(j)  (2304 + 64 * (j))
#define XB_TOP      3328
#define XB_TOPGEN   3392
#define XCD_BAR_WORDS 3456
#define XB_SPIN_CAP (1u << 18)

__device__ __forceinline__ unsigned xb_ld(unsigned* p)              { return __hip_atomic_load(p, __ATOMIC_RELAXED, __HIP_MEMORY_SCOPE_AGENT); }
__device__ __forceinline__ unsigned xb_add(unsigned* p, unsigned v) { return __hip_atomic_fetch_add(p, v, __ATOMIC_RELAXED, __HIP_MEMORY_SCOPE_AGENT); }
__device__ __forceinline__ unsigned xb_xcc_id() { return (unsigned)__builtin_amdgcn_s_getreg((3 << 11) | 20) & 0xFu; }
#define XB_SPIN(cond, bar) do { unsigned _sp = 0; while (cond) { __builtin_amdgcn_s_sleep(1); \
    if ((++_sp & 255u) == 0u) { if (xb_ld(&(bar)[XB_TMO])) break; if (_sp > XB_SPIN_CAP) { atomicAdd(&(bar)[XB_TMO], 1u); break; } } } } while (0)

struct XcdBarrier {
    unsigned* bar; unsigned x;
    volatile LAS unsigned* st;
};

__device__ __forceinline__ XcdBarrier xcd_barrier_post(unsigned* bar, volatile LAS unsigned* st) {
    XcdBarrier b; b.bar = bar; b.x = xb_xcc_id(); b.st = st;
    if (threadIdx.x == 0) (void)xb_add(&bar[XB_XCNT(b.x)], 1u);
    return b;
}
__device__ __forceinline__ void xcd_barrier_complete(unsigned* bar, unsigned x, unsigned& nloc, unsigned& nx) {
    const unsigned G = gridDim.x * gridDim.y * gridDim.z;
    unsigned sum, cnt, mine, sp = 0u;
    for (;;) {
        sum = 0u; cnt = 0u; mine = 0u;
#pragma unroll
        for (unsigned j = 0; j < 16; ++j) { const unsigned c = xb_ld(&bar[XB_XCNT(j)]); sum += c; cnt += (c > 0u) ? 1u : 0u; mine = (j == x) ? c : mine; }
        if (sum == G) break;
        __builtin_amdgcn_s_sleep(1);
        if ((++sp & 255u) == 0u) { if (xb_ld(&bar[XB_TMO])) break; if (sp > XB_SPIN_CAP) { atomicAdd(&bar[XB_TMO], 1u); break; } }
    }
    nloc = mine > 0u ? mine : 1u; nx = cnt > 0u ? cnt : 1u;
}

__device__ __forceinline__ void xcd_barrier(const XcdBarrier& b) {
    asm volatile("s_waitcnt vmcnt(0)" ::: "memory");
    __syncthreads();
    if (threadIdx.x == 0) {
        unsigned* bar = b.bar;
        __builtin_amdgcn_s_waitcnt(0);
        unsigned nloc = b.st[0], nx = b.st[1];
        if (nloc == 0u) { xcd_barrier_complete(bar, b.x, nloc, nx); b.st[0] = nloc; b.st[1] = nx; }
        const unsigned old = xb_add(&bar[XB_XSUB(b.x)], 1u);
        const unsigned gen = old / nloc;
        if (old + 1u == (gen + 1u) * nloc) {
            __builtin_amdgcn_fence(__ATOMIC_RELEASE, "agent");
            asm volatile("s_waitcnt vmcnt(0)" ::: "memory");
            const unsigned og = xb_add(&bar[XB_TOP], 1u);
            const unsigned tg = og / nx;
            if (og + 1u == (tg + 1u) * nx) xb_add(&bar[XB_TOPGEN], 1u);
            else XB_SPIN(xb_ld(&bar[XB_TOPGEN]) == tg, bar);
            __builtin_amdgcn_fence(__ATOMIC_ACQUIRE, "agent");
            xb_add(&bar[XB_XGEN(b.x)], 1u);
            asm volatile("s_waitcnt vmcnt(0)" ::: "memory");
        } else {
            XB_SPIN(xb_ld(&bar[XB_XGEN(b.x)]) == gen, bar);
            __builtin_amdgcn_fence(__ATOMIC_ACQUIRE, "agent");
            asm volatile("s_waitcnt vmcnt(0)" ::: "memory");
        }
    }
    __syncthreads();
}

constexpr int NWAVES = 8;
constexpr int BATCH = 8, SEQ = 2048, D = 1024, M = BATCH * SEQ, FF = 2816, NGU = 2 * FF, NINA = 5120, NING = 2048, NMOD = 9216;
constexpr float EPS = 1e-6f, LOG2E = 1.4426950408889634f, QSCALE = 0.125f * LOG2E;
#ifndef MK_N_LAUNCHES
#define MK_N_LAUNCHES 1
#endif
constexpr int N_PHASES = 14;
constexpr int NR4 = 4, NR11 = 4;

constexpr int N_LAUNCHES = MK_N_LAUNCHES;

constexpr size_t MiB = 1u << 20;
constexpr size_t WS_CTL = 0, CTL_ZERO_BYTES = 64 * 1024;
constexpr size_t WS_MOD = 1 * MiB;
constexpr size_t WS_BIAST = WS_MOD + 512 * 1024;
constexpr size_t WS_PAR = WS_BIAST + 8192;
constexpr size_t WS_WSP = WS_MOD + 768 * 1024;
constexpr size_t WS_GVSTAT = 2 * MiB;
constexpr size_t WS_WGU1 = 3 * MiB, WS_WD1 = WS_WGU1 + (size_t)NGU * D * 2, WS_WINA = WS_WD1 + (size_t)D * FF * 2, WS_WING = WS_WINA + (size_t)NINA * D * 2;
constexpr size_t WS_WA = WS_WING + (size_t)NING * D * 2, WS_WB = WS_WA + (size_t)D * D * 2, WS_WO = WS_WB + (size_t)D * D * 2;
constexpr size_t WS_WGU2 = WS_WO + (size_t)D * D * 2, WS_WD2 = WS_WGU2 + (size_t)NGU * D * 2, WS_WEND = WS_WD2 + (size_t)D * FF * 2;
constexpr size_t WS_XN = 56 * MiB;
constexpr size_t WS_ACT = 88 * MiB;
constexpr size_t ACT1 = (size_t)M * D * 2;
constexpr size_t WS_END = WS_ACT + 5 * ACT1;
static_assert(WS_WEND <= WS_XN && WS_XN + ACT1 <= WS_ACT && WS_END <= 256 * MiB && (size_t)M * FF * 2 <= 3 * ACT1, "d_ws map");
constexpr int CW_BAR = 1024;

constexpr int RING_OFF = 0, RING_BYTES = 131072;
constexpr int LDSCTL_OFF = RING_BYTES, MISC_OFF = LDSCTL_OFF + 320;
constexpr int LDS_BYTES = 147456;
constexpr int L_XCH = 98304, L_BIAS = 132096, L_WSF = 133120;

typedef float f32x16 __attribute__((ext_vector_type(16)));
typedef short s16x4 __attribute__((ext_vector_type(4)));
typedef unsigned v2u __attribute__((ext_vector_type(2)));
typedef short v4i16_t __attribute__((ext_vector_type(4)));

struct Args { const float* in[26]; float* out; unsigned char* ws; int ph_lo, ph_hi, li, pad; };
struct Frame {
    LAS unsigned char* lds;
    volatile LAS unsigned* MISC;
    gu32* ctl;
    int tid, lane, wave, vcu, G;
    const Args* a;
    unsigned char* ws;
    float* out;
};
#define IN_PTR(name, k) __device__ __forceinline__ const float* name(const Frame& F) { return F.a->in[k]; }
IN_PTR(p_x, 0) IN_PTR(p_c, 1) IN_PTR(p_w_ada, 2) IN_PTR(p_b_ada, 3) IN_PTR(p_w1g, 4) IN_PTR(p_w1u, 5) IN_PTR(p_w1d, 6) IN_PTR(p_w_in, 7) IN_PTR(p_q_g, 8) IN_PTR(p_k_g, 9)
IN_PTR(p_lq1, 10) IN_PTR(p_lk1, 11) IN_PTR(p_lq2, 12) IN_PTR(p_lk2, 13) IN_PTR(p_sub_g, 14) IN_PTR(p_relb, 15) IN_PTR(p_ln_g, 16) IN_PTR(p_ln_b, 17) IN_PTR(p_w_sp, 18) IN_PTR(p_b_sp, 19)
IN_PTR(p_w_a, 20) IN_PTR(p_w_b, 21) IN_PTR(p_w_o, 22) IN_PTR(p_w2g, 23) IN_PTR(p_w2u, 24) IN_PTR(p_w2d, 25)
#define WS_F32(name, off) __device__ __forceinline__ float* name(const Frame& F) { return (float*)(F.ws + (off)); }
#define WS_B16(name, off) __device__ __forceinline__ bf16* name(const Frame& F) { return (bf16*)(F.ws + (off)); }
WS_F32(p_MOD, WS_MOD) WS_F32(p_BIAST, WS_BIAST) WS_F32(p_PAR, WS_PAR) WS_F32(p_GVSTAT, WS_GVSTAT)
WS_B16(p_WSP, WS_WSP) WS_B16(p_WGU1, WS_WGU1) WS_B16(p_WD1, WS_WD1) WS_B16(p_WINA, WS_WINA) WS_B16(p_WING, WS_WING) WS_B16(p_WA, WS_WA) WS_B16(p_WB, WS_WB) WS_B16(p_WO, WS_WO) WS_B16(p_WGU2, WS_WGU2) WS_B16(p_WD2, WS_WD2)
__device__ __forceinline__ bf16* p_X1B(const Frame& F) { return (bf16*)F.out; }
WS_B16(p_X2B, WS_ACT + 3 * ACT1)
WS_B16(p_XN, WS_XN) WS_B16(p_Q, WS_ACT) WS_B16(p_K, WS_ACT + ACT1) WS_B16(p_V, WS_ACT + 2 * ACT1) WS_B16(p_U, WS_ACT + 3 * ACT1) WS_B16(p_GV, WS_ACT + 4 * ACT1) WS_B16(p_H, WS_ACT)


__device__ __forceinline__ float wave_sum(float v) {
#pragma unroll
    for (int o = 1; o < 64; o <<= 1) v += __shfl_xor(v, o);
    return v;
}
__device__ __forceinline__ float wave_max(float v) {
#pragma unroll
    for (int o = 1; o < 64; o <<= 1) v = fmaxf(v, __shfl_xor(v, o));
    return v;
}
__device__ __forceinline__ float bflo(unsigned w) { return __uint_as_float(w << 16); }
__device__ __forceinline__ float bfhi(unsigned w) { return __uint_as_float(w & 0xffff0000u); }

__device__ __forceinline__ void p0_transpose_item(const float* W, int ldw, int K, bf16* WT, int rowbase, int k0, int n0, LAS float* scr, int lane) {
    float tv[32];
#pragma unroll
    for (int i = 0; i < 32; ++i) tv[i] = W[(size_t)(k0 + 2 * i + (lane >> 5)) * ldw + n0 + (lane & 31)];
#pragma unroll
    for (int i = 0; i < 32; ++i) scr[(2 * i + (lane >> 5)) * 33 + (lane & 31)] = tv[i];
    LDS_WAIT(); asm volatile("" ::: "memory");
    const int c = lane & 7;
#pragma unroll
    for (int j = 0; j < 4; ++j) { const int n = (lane >> 3) + 8 * j; const LAS float* s = scr + (8 * c) * 33 + n;
        v4u o; o.x = pk2(s[0 * 33], s[1 * 33]); o.y = pk2(s[2 * 33], s[3 * 33]); o.z = pk2(s[4 * 33], s[5 * 33]); o.w = pk2(s[6 * 33], s[7 * 33]);
        *(GAS v4u*)(WT + (size_t)(rowbase + n) * K + k0 + 8 * c) = o; }
    LDS_WAIT(); asm volatile("" ::: "memory");
}
__device__ __forceinline__ void p0_tr_plain(const float* W, int K, int N, bf16* WT, int item, LAS float* scr, int lane) {
    const int nblk = N / 32, kb = item / nblk, nb = item % nblk;
    p0_transpose_item(W, N, K, WT, 32 * nb, 64 * kb, 32 * nb, scr, lane);
}
__device__ __forceinline__ void p0_tr_gu(const float* W, bf16* WT, int up, int item, LAS float* scr, int lane) {
    const int nblk = FF / 32, kb = item / nblk, nb = item % nblk, n0 = 32 * nb;
    p0_transpose_item(W, FF, D, WT, 256 * (n0 >> 7) + 128 * up + (n0 & 127), 64 * kb, n0, scr, lane);
}
__device__ __forceinline__ void p0_tr_in(Frame& F, int item, LAS float* scr, int lane) {
    const int nblk = 7168 / 32, kb = item / nblk, nb = item % nblk, n0 = 32 * nb;
    bf16* WT = p_WINA(F); int rb = n0;
    if (n0 < 2048) rb = (n0 & ~255) + 128 * ((n0 & 63) >> 5) + 32 * ((n0 & 255) >> 6);
    else if (n0 >= NINA) { WT = p_WING(F); rb = n0 - NINA; }
    p0_transpose_item(p_w_in(F), 7168, D, WT, rb, 64 * kb, n0, scr, lane);
}
__device__ __forceinline__ void p0_prologue(Frame& F) {
    {
        LAS float* sl = (LAS float*)(F.lds);
        LAS float* red = sl + 8192;
        for (int i = F.tid; i < 8192; i += NWAVES * 64) { const float v = p_c(F)[i]; sl[i] = v / (1.0f + __expf(-v)); }
        __syncthreads();
        const int cl = F.tid % 36, kl = F.tid / 36;
        for (int item = F.vcu; item < 256; item += F.G) {
            const int n0 = item * 36;
            if (kl < 14) {
                float a0 = 0.f, a1 = 0.f, a2 = 0.f, a3 = 0.f, a4 = 0.f, a5 = 0.f, a6 = 0.f, a7 = 0.f;
                const float* wp = p_w_ada(F) + n0 + cl;
                for (int k0 = kl; k0 < 1024; k0 += 14 * 8) {
                    float w[8];
#pragma unroll
                    for (int u = 0; u < 8; ++u) { const int k = k0 + 14 * u; w[u] = wp[(size_t)(k < 1024 ? k : 1023) * NMOD]; }
#pragma unroll
                    for (int u = 0; u < 8; ++u) { const int k = k0 + 14 * u; const int kc = k < 1024 ? k : 1023; const float wv = k < 1024 ? w[u] : 0.f;
                        a0 += sl[kc] * wv; a1 += sl[1024 + kc] * wv; a2 += sl[2048 + kc] * wv; a3 += sl[3072 + kc] * wv; a4 += sl[4096 + kc] * wv; a5 += sl[5120 + kc] * wv; a6 += sl[6144 + kc] * wv; a7 += sl[7168 + kc] * wv; } }
                LAS float* r = red + kl * 288 + cl;
                r[0] = a0; r[36] = a1; r[72] = a2; r[108] = a3; r[144] = a4; r[180] = a5; r[216] = a6; r[252] = a7;
            }
            __syncthreads();
            if (F.tid < 288) { float s = p_b_ada(F)[n0 + (F.tid % 36)];
#pragma unroll
                for (int q = 0; q < 14; ++q) s += red[q * 288 + F.tid];
                p_MOD(F)[(size_t)(F.tid / 36) * NMOD + n0 + (F.tid % 36)] = s; }
            __syncthreads();
        }
    }
    if (F.vcu == 0) {
        if (F.wave == 0) {
            const float a = wave_sum(p_lq1(F)[F.lane] * p_lk1(F)[F.lane]), b = wave_sum(p_lq2(F)[F.lane] * p_lk2(F)[F.lane]);
            if (F.lane == 0) p_PAR(F)[0] = __expf(a) - __expf(b) + 0.2f;
        } else {
            const float gq = wave_max(fabsf(p_q_g(F)[F.lane])), gk = wave_max(fabsf(p_k_g(F)[F.lane]));
            for (int h = F.wave - 1; h < 8; h += 7) {
                const float tb = wave_max(F.lane < 32 ? fabsf(p_relb(F)[F.lane * 8 + h]) : 0.f);
                const float bound2 = (1.02f * 8.0f * gq * gk + 2.0f * tb) * LOG2E;
                const float xs = fmaxf(bound2 - 100.0f, 0.0f);
                if (F.lane == 0) p_PAR(F)[8 + h] = xs;
                for (int n = F.lane; n <= 128; n += 64) {
                    int bk = n;
                    if (n >= 16) { bk = 16 + (int)(logf((float)n / 16.0f) / logf(8.0f) * 16.0f); bk = bk > 31 ? 31 : bk; }
                    p_BIAST(F)[h * 160 + n] = (p_relb(F)[bk * 8 + h] - p_relb(F)[31 * 8 + h]) * LOG2E - xs;
                }
            }
        }
    }
    for (int i = F.vcu * (NWAVES * 64) + F.tid; i < 2 * M; i += F.G * NWAVES * 64) p_GVSTAT(F)[i] = 0.f;
    for (int i = F.vcu * (NWAVES * 64) + F.tid; i < 8 * 128 * 128; i += F.G * NWAVES * 64) {
        const int s = i & 127, t = (i >> 7) & 127; p_WSP(F)[i] = (s <= t) ? (bf16)f2bf(p_w_sp(F)[i]) : (bf16)0; }
    LAS float* scr = (LAS float*)(F.lds + RING_OFF + F.wave * 16384);
    __syncthreads();
    const int gw = F.vcu * NWAVES + F.wave, NGW = F.G * NWAVES;
    constexpr int I_GU = (D / 64) * (FF / 32), I_D = (FF / 64) * (D / 32), I_P = (D / 64) * (D / 32);
    constexpr int NITEMS = 4 * I_GU;
    for (int it = gw; it < NITEMS; it += NGW) {
        int r = it;
        if (r < I_GU) { p0_tr_gu(p_w1g(F), p_WGU1(F), 0, r, scr, F.lane); continue; } r -= I_GU;
        if (r < I_GU) { p0_tr_gu(p_w1u(F), p_WGU1(F), 1, r, scr, F.lane); continue; } r -= I_GU;
        if (r < I_GU) { p0_tr_gu(p_w2g(F), p_WGU2(F), 0, r, scr, F.lane); continue; } r -= I_GU;
        p0_tr_gu(p_w2u(F), p_WGU2(F), 1, r, scr, F.lane);
    }
}
__device__ __forceinline__ void p2_tail_convert(Frame& F, int first_idle) {
    LAS float* scr = (LAS float*)(F.lds + RING_OFF + F.wave * 16384);
    constexpr int I_D = (FF / 64) * (D / 32), I_IN = (D / 64) * (7168 / 32), I_P = (D / 64) * (D / 32);
    const int nw = (F.G - first_idle) * NWAVES;
    for (int it = ((int)blockIdx.x - first_idle) * NWAVES + F.wave; it < I_D + I_IN + 3 * I_P; it += nw) {
        int r = it;
        if (r < I_D) { p0_tr_plain(p_w1d(F), FF, D, p_WD1(F), r, scr, F.lane); continue; } r -= I_D;
        if (r < I_IN) { p0_tr_in(F, r, scr, F.lane); continue; } r -= I_IN;
        if (r < I_P) { p0_tr_plain(p_w_a(F), D, D, p_WA(F), r, scr, F.lane); continue; } r -= I_P;
        if (r < I_P) { p0_tr_plain(p_w_b(F), D, D, p_WB(F), r, scr, F.lane); continue; } r -= I_P;
        p0_tr_plain(p_w_o(F), D, D, p_WO(F), r, scr, F.lane);
    }
}

__device__ __forceinline__ void p12_tail_convert(Frame& F, int first_idle) {
    LAS float* scr = (LAS float*)(F.lds + RING_OFF + F.wave * 16384);
    constexpr int I_D = (FF / 64) * (D / 32);
    const int nw = (F.G - first_idle) * NWAVES;
    for (int it = ((int)blockIdx.x - first_idle) * NWAVES + F.wave; it < I_D; it += nw) p0_tr_plain(p_w2d(F), FF, D, p_WD2(F), it, scr, F.lane);
}

__device__ __forceinline__ void norm_rows(Frame& F, const float* src, int sub) {
    const int gw = F.vcu * NWAVES + F.wave, NGW = F.G * NWAVES;
    for (int base = gw * 8; base < M; base += NGW * 8) {
        const float* sh = p_MOD(F) + (size_t)(base >> 11) * NMOD + (3 * sub) * 1024; const float* sc = sh + 1024;
        f32x4 a[4], b[4];
#pragma unroll
        for (int j = 0; j < 4; ++j) { a[j] = *((const GAS f32x4*)sc + F.lane + 64 * j) + 1.0f; b[j] = *((const GAS f32x4*)sh + F.lane + 64 * j); }
#pragma unroll
        for (int half = 0; half < 2; ++half) {
            f32x4 v[4][4]; float s[4];
#pragma unroll
            for (int r = 0; r < 4; ++r) { const GAS f32x4* xr = (const GAS f32x4*)(src + (size_t)(base + 4 * half + r) * D) + F.lane;
#pragma unroll
                for (int j = 0; j < 4; ++j) v[r][j] = xr[64 * j]; }
#pragma unroll
            for (int r = 0; r < 4; ++r) { float t = 0.f;
#pragma unroll
                for (int j = 0; j < 4; ++j) t += (v[r][j].x * v[r][j].x + v[r][j].y * v[r][j].y) + (v[r][j].z * v[r][j].z + v[r][j].w * v[r][j].w);
                s[r] = t; }
#pragma unroll
            for (int o = 1; o < 64; o <<= 1) {
#pragma unroll
                for (int r = 0; r < 4; ++r) s[r] += __shfl_xor(s[r], o); }
#pragma unroll
            for (int r = 0; r < 4; ++r) { const float rstd = 1.0f / sqrtf(s[r] * (1.f / D) + EPS);
                GAS unsigned long long* o8 = (GAS unsigned long long*)(p_XN(F) + (size_t)(base + 4 * half + r) * D) + F.lane;
#pragma unroll
                for (int j = 0; j < 4; ++j) { const f32x4 o = v[r][j] * rstd * a[j] + b[j];
                    o8[64 * j] = (unsigned long long)pk2(o.x, o.y) | ((unsigned long long)pk2(o.z, o.w) << 32); } }
        }
    }
}
template <int R> __device__ __forceinline__ void norm_rows_b16(Frame& F, const bf16* src, int sub) {
    const int gw = F.vcu * NWAVES + F.wave, NGW = F.G * NWAVES, lane = F.lane;
    for (int base = gw * 8; base < M; base += NGW * 8) {
        const float* sh = p_MOD(F) + (size_t)(base >> 11) * NMOD + (3 * sub) * 1024 + lane * 16; const float* sc = sh + 1024;
        f32x4 a[4], b[4];
#pragma unroll
        for (int j = 0; j < 4; ++j) { a[j] = *((const GAS f32x4*)sc + j) + 1.0f; b[j] = *((const GAS f32x4*)sh + j); }
#pragma unroll 1
        for (int half = 0; half < 8 / R; ++half) {
            v4u w0[R], w1[R]; float s[R];
#pragma unroll
            for (int r = 0; r < R; ++r) { const bf16* p = src + (size_t)(base + R * half + r) * D + lane * 16; w0[r] = *(const GAS v4u*)p; w1[r] = *(const GAS v4u*)(p + 8); }
            f32x4 v[R][4];
#pragma unroll
            for (int r = 0; r < R; ++r) { v[r][0] = (f32x4){bflo(w0[r].x), bfhi(w0[r].x), bflo(w0[r].y), bfhi(w0[r].y)}; v[r][1] = (f32x4){bflo(w0[r].z), bfhi(w0[r].z), bflo(w0[r].w), bfhi(w0[r].w)};
                v[r][2] = (f32x4){bflo(w1[r].x), bfhi(w1[r].x), bflo(w1[r].y), bfhi(w1[r].y)}; v[r][3] = (f32x4){bflo(w1[r].z), bfhi(w1[r].z), bflo(w1[r].w), bfhi(w1[r].w)};
                float t = 0.f;
#pragma unroll
                for (int j = 0; j < 4; ++j) t += (v[r][j].x * v[r][j].x + v[r][j].y * v[r][j].y) + (v[r][j].z * v[r][j].z + v[r][j].w * v[r][j].w);
                s[r] = t; }
#pragma unroll
            for (int o = 1; o < 64; o <<= 1) {
#pragma unroll
                for (int r = 0; r < R; ++r) s[r] += __shfl_xor(s[r], o); }
#pragma unroll
            for (int r = 0; r < R; ++r) { const float rstd = 1.0f / sqrtf(s[r] * (1.f / D) + EPS);
                f32x4 o[4];
#pragma unroll
                for (int j = 0; j < 4; ++j) o[j] = v[r][j] * rstd * a[j] + b[j];
                bf16* q = p_XN(F) + (size_t)(base + R * half + r) * D + lane * 16;
                v4u x0, x1; x0.x = pk2(o[0].x, o[0].y); x0.y = pk2(o[0].z, o[0].w); x0.z = pk2(o[1].x, o[1].y); x0.w = pk2(o[1].z, o[1].w); x1.x = pk2(o[2].x, o[2].y); x1.y = pk2(o[2].z, o[2].w); x1.z = pk2(o[3].x, o[3].y); x1.w = pk2(o[3].z, o[3].w);
                *(GAS v4u*)q = x0; *(GAS v4u*)(q + 8) = x1; }
        }
    }
}
__device__ __forceinline__ int crow(int r, int hi) { return (r & 3) + 8 * (r >> 2) + 4 * hi; }
__device__ __forceinline__ s16x4 vtr(const LAS unsigned char* p) { return __builtin_bit_cast(s16x4, __builtin_amdgcn_ds_read_tr16_b64_v4i16((LAS v4i16_t*)p)); }
__device__ __forceinline__ bf16x8 pack8f(const f32x16& p, int b) {
    v4u w; w.x = pg8::cvt_pk_bf16(p[b], p[b + 1]); w.y = pg8::cvt_pk_bf16(p[b + 2], p[b + 3]); w.z = pg8::cvt_pk_bf16(p[b + 4], p[b + 5]); w.w = pg8::cvt_pk_bf16(p[b + 6], p[b + 7]);
    return __builtin_bit_cast(bf16x8, w);
}
__device__ __forceinline__ void glds16s(const void* sbase, unsigned voff, unsigned lds_dst) {
    unsigned keep;
    asm volatile("s_mov_b32 %0, m0\n\ts_mov_b32 m0, %3\n\ts_nop 0\n\tglobal_load_lds_dwordx4 %1, %2\n\ts_mov_b32 m0, %0" : "=&s"(keep) : "v"(voff), "s"(sbase), "s"(lds_dst) : "memory");
}
#define ATT_WAIT_BAR(N) asm volatile("s_waitcnt vmcnt(" #N ") lgkmcnt(0)\n\ts_barrier" ::: "memory")
struct AttnDma { unsigned ko[2], vo[2]; };
__device__ __forceinline__ AttnDma attn_dma_setup(int wid, int lane) {
    AttnDma d;
#pragma unroll
    for (int i = 0; i < 2; ++i) { const int p = wid + 8 * i; const int kv = 4 * p + (lane >> 4), ch = (lane & 15) ^ (kv & 15);
        d.ko[i] = (unsigned)((kv * D + ch * 8) * 2);
        const int kv2 = 16 * (p & 3) + (lane >> 2);
        d.vo[i] = (unsigned)((kv2 * D + (p >> 2) * 32 + (lane & 3) * 8) * 2); }
    return d;
}
__device__ __forceinline__ void attn_dma_tile(LAS unsigned char* lds, int buf, const bf16* Kg, const bf16* Vg, int t, int wid, const AttnDma& d) {
    const unsigned kb = (unsigned)(size_t)lds + (unsigned)buf * 32768u, vb = kb + 16384u;
    const bf16* kt = Kg + (size_t)(64 * t) * D; const bf16* vt = Vg + (size_t)(64 * t) * D;
#pragma unroll
    for (int i = 0; i < 2; ++i) { const int p = wid + 8 * i;
        glds16s(kt, d.ko[i], (unsigned)__builtin_amdgcn_readfirstlane(kb + p * 1024));
        glds16s(vt, d.vo[i], (unsigned)__builtin_amdgcn_readfirstlane(vb + p * 1024)); }
}
template <bool SLOW> __device__ __forceinline__ void attn_tile(const LAS unsigned char* kb, const LAS unsigned char* vp, const LAS float* biasL, const bf16x8 (&qr)[4], f32x16 (&o)[4], float& l,
                                                                int map, int r32, int hi, int nbase  ) {
    f32x16 p0 = f32x16{}, p1 = f32x16{};
#pragma unroll
    for (int d0 = 0; d0 < 4; ++d0) { const int ch = map * 8 + 2 * d0 + hi, sw = (ch ^ (r32 & 15)) << 4;
        const bf16x8 k0 = *(const LAS bf16x8*)(kb + r32 * 256 + sw), k1 = *(const LAS bf16x8*)(kb + (r32 + 32) * 256 + sw);
        p0 = __builtin_amdgcn_mfma_f32_32x32x16_bf16(k0, qr[d0], p0, 0, 0, 0); p1 = __builtin_amdgcn_mfma_f32_32x32x16_bf16(k1, qr[d0], p1, 0, 0, 0); }
    float s = 0.f;
    if (SLOW) {
#pragma unroll
        for (int r = 0; r < 16; ++r) { const int n0 = nbase - crow(r, hi), n1 = n0 - 32;
            const float b0 = biasL[min(max(n0, 0), 128)], b1 = biasL[min(max(n1, 0), 128)];
            float e0 = __builtin_amdgcn_exp2f(p0[r] + b0), e1 = __builtin_amdgcn_exp2f(p1[r] + b1);
            e0 = n0 >= 0 ? e0 : 0.f; e1 = n1 >= 0 ? e1 : 0.f;
            p0[r] = e0; p1[r] = e1; s += e0 + e1; }
    } else {
#pragma unroll
        for (int r = 0; r < 16; ++r) { const float e0 = __builtin_amdgcn_exp2f(p0[r]), e1 = __builtin_amdgcn_exp2f(p1[r]); p0[r] = e0; p1[r] = e1; s += e0 + e1; }
    }
    l += s;
    const bf16x8 pw0 = pack8f(p0, 0), pw1 = pack8f(p0, 8), pw2 = pack8f(p1, 0), pw3 = pack8f(p1, 8);
#pragma unroll
    for (int d0 = 0; d0 < 4; ++d0) {
#define VF(ks) ({ const s16x4 lo_ = vtr(vp + d0 * 4096 + (ks) * 1024), hh_ = vtr(vp + d0 * 4096 + (ks) * 1024 + 512); (bf16x8){lo_[0], lo_[1], lo_[2], lo_[3], hh_[0], hh_[1], hh_[2], hh_[3]}; })
        o[d0] = __builtin_amdgcn_mfma_f32_32x32x16_bf16(pw0, VF(0), o[d0], 0, 0, 0);
        o[d0] = __builtin_amdgcn_mfma_f32_32x32x16_bf16(pw1, VF(1), o[d0], 0, 0, 0);
        o[d0] = __builtin_amdgcn_mfma_f32_32x32x16_bf16(pw2, VF(2), o[d0], 0, 0, 0);
        o[d0] = __builtin_amdgcn_mfma_f32_32x32x16_bf16(pw3, VF(3), o[d0], 0, 0, 0);
#undef VF
    }
}
__device__ __forceinline__ void attn_units(Frame& F, int b, int h, int s) {
    const int tid = F.tid, lane = F.lane, r32 = lane & 31, hi = lane >> 5, wid = F.wave, map = wid >> 2, wq = wid & 3;
    LAS unsigned char* lds = F.lds;
    LAS float* biasL = (LAS float*)(lds + L_BIAS);
    LAS float* wsf = (LAS float*)(lds + L_WSF) + wid * 64;
    LAS unsigned* xw = (LAS unsigned*)(lds + L_XCH) + wq * 2048;
    const size_t rowbase = (size_t)b * SEQ;
    const bf16* Kg = p_K(F) + rowbase * D + h * 128; const bf16* Vg = p_V(F) + rowbase * D + h * 128;
    const bf16* Qg = p_Q(F) + (rowbase + wq * 32 + r32) * D + h * 128 + map * 64 + hi * 8;
    const AttnDma dd = attn_dma_setup(wid, lane);
    const int voff = ((lane >> 4) & 1) * 32 + (lane & 3) * 8 + (4 * hi + ((lane & 15) >> 2)) * 64;
    __syncthreads();
    attn_dma_tile(lds, 0, Kg, Vg, 0, wid, dd);
    attn_dma_tile(lds, 1, Kg, Vg, 1, wid, dd);
    if (tid < 129) biasL[tid] = p_BIAST(F)[h * 160 + tid];
    const bool slow_all = p_PAR(F)[8 + h] != 0.0f;
    const float lam = p_PAR(F)[0];
    float gs[4];
#pragma unroll
    for (int d0 = 0; d0 < 4; ++d0) gs[d0] = p_sub_g(F)[32 * d0 + r32] * 0.8f;
    bf16x8 qr[4];
#pragma unroll
    for (int d0 = 0; d0 < 4; ++d0) qr[d0] = __builtin_bit_cast(bf16x8, *(const GAS v4u*)(Qg + (size_t)(128 * s) * D + d0 * 16));
#pragma unroll 1
    for (int ui = 0; ui < 4; ++ui) {
        const int qb = ui == 0 ? s : ui == 1 ? 7 - s : ui == 2 ? 8 + s : 15 - s, q0 = qb * 128, NT = 2 * (qb + 1), qpos = q0 + wq * 32 + r32;
        asm volatile("" : "+v"(qr[0]), "+v"(qr[1]), "+v"(qr[2]), "+v"(qr[3]));
        f32x16 o[4];
#pragma unroll
        for (int i = 0; i < 4; ++i) o[i] = f32x16{};
        float l = 0.f;
        const int nfast = slow_all ? 0 : (NT - 4 > 0 ? NT - 4 : 0);
        int t = 0, bufc = 0;
        for (; t < nfast; ++t) {
            ATT_WAIT_BAR(4);
            attn_dma_tile(lds, bufc == 0 ? 2 : bufc - 1, Kg, Vg, t + 2, wid, dd);
            const LAS unsigned char* kb = lds + bufc * 32768;
            attn_tile<false>(kb, kb + 16384 + voff, biasL, qr, o, l, map, r32, hi, qpos - 64 * t);
            bufc = bufc == 2 ? 0 : bufc + 1;
        }
        for (; t < NT; ++t) {
            if (t + 1 < NT) ATT_WAIT_BAR(4); else ATT_WAIT_BAR(0);
            if (t + 2 < NT) attn_dma_tile(lds, bufc == 0 ? 2 : bufc - 1, Kg, Vg, t + 2, wid, dd);
            const LAS unsigned char* kb = lds + bufc * 32768;
            attn_tile<true>(kb, kb + 16384 + voff, biasL, qr, o, l, map, r32, hi, qpos - 64 * t);
            bufc = bufc == 2 ? 0 : bufc + 1;
        }
        l += __shfl_xor(l, 32);
        if (hi == 0) wsf[r32] = map ? lam / l : 1.0f / l;
        LDS_WAIT();
        __syncthreads();
        if (ui < 3) { const int qn = ui == 0 ? 7 - s : ui == 1 ? 8 + s : 15 - s;
            attn_dma_tile(lds, 0, Kg, Vg, 0, wid, dd);
            attn_dma_tile(lds, 1, Kg, Vg, 1, wid, dd);
#pragma unroll
            for (int d0 = 0; d0 < 4; ++d0) qr[d0] = __builtin_bit_cast(bf16x8, *(const GAS v4u*)(Qg + (size_t)(128 * qn) * D + d0 * 16)); }
        if (map) {
#pragma unroll
            for (int r = 0; r < 16; r += 2) { const float ia = wsf[crow(r, hi)], ib = wsf[crow(r + 1, hi)];
#pragma unroll
                for (int d0 = 0; d0 < 4; ++d0) xw[(d0 * 8 + (r >> 1)) * 64 + lane] = pg8::cvt_pk_bf16(o[d0][r] * ia, o[d0][r + 1] * ib); }
        }
        __syncthreads();
        if (!map) {
            f32x16 a[4];
#pragma unroll
            for (int r = 0; r < 16; r += 2) { const float ia = wsf[crow(r, hi)], ib = wsf[crow(r + 1, hi)]; float sa = 0.f, sb = 0.f;
#pragma unroll
                for (int d0 = 0; d0 < 4; ++d0) { const unsigned w = xw[(d0 * 8 + (r >> 1)) * 64 + lane]; const float va = o[d0][r] * ia - bflo(w), vb = o[d0][r + 1] * ib - bfhi(w); a[d0][r] = va; a[d0][r + 1] = vb; sa += va * va; sb += vb * vb; }
                sa += __shfl_xor(sa, 1); sb += __shfl_xor(sb, 1); sa += __shfl_xor(sa, 2); sb += __shfl_xor(sb, 2); sa += __shfl_xor(sa, 4); sb += __shfl_xor(sb, 4); sa += __shfl_xor(sa, 8); sb += __shfl_xor(sb, 8); sa += __shfl_xor(sa, 16); sb += __shfl_xor(sb, 16);
                const float ra = 1.0f / sqrtf(sa * (1.f / 128.f) + EPS), rb = 1.0f / sqrtf(sb * (1.f / 128.f) + EPS);
#pragma unroll
                for (int d0 = 0; d0 < 4; ++d0) { a[d0][r] *= ra * gs[d0]; a[d0][r + 1] *= rb * gs[d0]; } }
            LAS bf16* stg = (LAS bf16*)xw;
            LDS_WAIT();
#pragma unroll
            for (int r = 0; r < 16; ++r)
#pragma unroll
                for (int d0 = 0; d0 < 4; ++d0) stg[crow(r, hi) * 128 + 32 * d0 + r32] = (bf16)f2bf(a[d0][r]);
            LDS_WAIT();
            bf16* Ow = p_Q(F) + (rowbase + q0 + wq * 32) * D + h * 128;
#pragma unroll
            for (int i = 0; i < 8; ++i) { const int row = i * 4 + (lane >> 4), ch = lane & 15; *(GAS v4u*)(Ow + (size_t)row * D + ch * 8) = *(const LAS v4u*)(stg + row * 128 + ch * 8); }
        }
    }
}
struct GmlpRegs { v4u raw[4]; float s1[4], s2[4]; unsigned uu[16]; };
__device__ __forceinline__ void gmlp_load(Frame& F, int unit, GmlpRegs& R) {
    const int tid = F.tid, lane = F.lane, r32 = lane & 31, hi = lane >> 5, wid = F.wave;
    const int b = unit >> 7, nc = (unit >> 3) & 15, g = unit & 7;
    const size_t t0 = (size_t)b * SEQ + 128 * nc; const int c0 = 128 * g;
    const int s_ = tid >> 4, ch = tid & 15, tb = wid >> 1, cbb = 2 * (wid & 1);
#pragma unroll
    for (int i = 0; i < 4; ++i) { const int s = s_ + 32 * i; R.raw[i] = *(const GAS v4u*)(p_GV(F) + (t0 + s) * D + c0 + ch * 8); R.s1[i] = p_GVSTAT(F)[2 * (t0 + s)]; R.s2[i] = p_GVSTAT(F)[2 * (t0 + s) + 1]; }
    const bf16* ub = p_U(F) + (t0 + 32 * tb) * D + c0 + 32 * cbb + r32;
#pragma unroll
    for (int r = 0; r < 16; ++r) { const int tl = crow(r, hi); R.uu[r] = (unsigned)ub[(size_t)tl * D] | ((unsigned)ub[(size_t)tl * D + 32] << 16); }
}
__device__ __forceinline__ void gmlp_compute(Frame& F, int unit, const GmlpRegs& R) {
    const int tid = F.tid, lane = F.lane, r32 = lane & 31, hi = lane >> 5, wid = F.wave;
    LAS unsigned char* lds = F.lds;
    const int b = unit >> 7, nc = (unit >> 3) & 15, g = unit & 7;
    const size_t t0 = (size_t)b * SEQ + 128 * nc; const int c0 = 128 * g;
    const int s_ = tid >> 4, ch = tid & 15, tb = wid >> 1, cbb = 2 * (wid & 1);
    const f32x4 lg0 = *(const GAS f32x4*)(p_ln_g(F) + c0 + ch * 8), lg1 = *(const GAS f32x4*)(p_ln_g(F) + c0 + ch * 8 + 4), lb0 = *(const GAS f32x4*)(p_ln_b(F) + c0 + ch * 8), lb1 = *(const GAS f32x4*)(p_ln_b(F) + c0 + ch * 8 + 4);
    const bf16* Wr = p_WSP(F) + ((size_t)g * 128 + 32 * tb + r32) * 128 + 4 * hi;
    v2u alo[8], ahi[8];
#pragma unroll
    for (int ks = 0; ks < 8; ++ks) { alo[ks] = *(const GAS v2u*)(Wr + 16 * ks); ahi[ks] = *(const GAS v2u*)(Wr + 16 * ks + 8); }
    float bs[16];
#pragma unroll
    for (int r = 0; r < 16; ++r) bs[r] = p_b_sp(F)[g * 128 + 32 * tb + crow(r, hi)];
    __syncthreads();
    { const float lgv[8] = {lg0.x, lg0.y, lg0.z, lg0.w, lg1.x, lg1.y, lg1.z, lg1.w}, lbv[8] = {lb0.x, lb0.y, lb0.z, lb0.w, lb1.x, lb1.y, lb1.z, lb1.w};
#pragma unroll
      for (int i = 0; i < 4; ++i) { const int s = s_ + 32 * i;
          const float mean = R.s1[i] * (1.f / D); const float rstd = 1.0f / sqrtf(fmaxf(R.s2[i] * (1.f / D) - mean * mean, 0.f) + EPS);
          const float x[8] = {bflo(R.raw[i].x), bfhi(R.raw[i].x), bflo(R.raw[i].y), bfhi(R.raw[i].y), bflo(R.raw[i].z), bfhi(R.raw[i].z), bflo(R.raw[i].w), bfhi(R.raw[i].w)};
          float y[8];
#pragma unroll
          for (int e = 0; e < 8; ++e) y[e] = (x[e] - mean) * rstd * lgv[e] + lbv[e];
          v4u o; o.x = pk2(y[0], y[1]); o.y = pk2(y[2], y[3]); o.z = pk2(y[4], y[5]); o.w = pk2(y[6], y[7]);
          *(LAS v4u*)(lds + (s >> 6) * 16384 + (ch >> 2) * 4096 + ((s & 63) >> 4) * 1024 + (s & 15) * 64 + (ch & 3) * 16) = o; } }
    __syncthreads();
    f32x16 acc0 = f32x16{}, acc1 = f32x16{};
    const LAS unsigned char* vp = lds + ((lane >> 4) & 1) * 32 + (lane & 3) * 8 + (4 * hi + ((lane & 15) >> 2)) * 64;
#pragma unroll
    for (int ks = 0; ks < 8; ++ks) {
        if (ks < 2 * (tb + 1)) {
            const bf16x8 af = __builtin_bit_cast(bf16x8, (v4u){alo[ks].x, alo[ks].y, ahi[ks].x, ahi[ks].y});
            const LAS unsigned char* vt = vp + (ks >> 2) * 16384 + (ks & 3) * 1024 + cbb * 4096;
            const s16x4 l0 = vtr(vt), h0 = vtr(vt + 512), l1 = vtr(vt + 4096), h1 = vtr(vt + 4096 + 512);
            acc0 = __builtin_amdgcn_mfma_f32_32x32x16_bf16(af, (bf16x8){l0[0], l0[1], l0[2], l0[3], h0[0], h0[1], h0[2], h0[3]}, acc0, 0, 0, 0);
            acc1 = __builtin_amdgcn_mfma_f32_32x32x16_bf16(af, (bf16x8){l1[0], l1[1], l1[2], l1[3], h1[0], h1[1], h1[2], h1[3]}, acc1, 0, 0, 0);
        }
    }
    bf16* ub = p_U(F) + (t0 + 32 * tb) * D + c0 + 32 * cbb + r32;
#pragma unroll
    for (int r = 0; r < 16; ++r) { const int tl = crow(r, hi);
        ub[(size_t)tl * D] = (bf16)f2bf((acc0[r] + bs[r]) * bflo(R.uu[r])); ub[(size_t)tl * D + 32] = (bf16)f2bf((acc1[r] + bs[r]) * bfhi(R.uu[r])); }
}
__device__ __forceinline__ void gmlp_units(Frame& F, int first, int stride) {
    if (first >= 1024) return;
    GmlpRegs A, B; gmlp_load(F, first, A);
#pragma unroll 1
    for (int i = first; i < 1024; i += 2 * stride) {
        const bool m1 = i + stride < 1024, m2 = i + 2 * stride < 1024;
        if (m1) gmlp_load(F, i + stride, B);
        gmlp_compute(F, i, A);
        if (!m1) break;
        if (m2) gmlp_load(F, i + 2 * stride, A);
        gmlp_compute(F, i + stride, B);
    }
}

__global__ void __launch_bounds__(NWAVES * 64, 2) mk_fwd(Args args) {
    extern __shared__ __attribute__((aligned(16))) unsigned char lds[];
    Frame F;
    F.lds = (LAS unsigned char*)lds;
    F.MISC = (volatile LAS unsigned*)(F.lds + MISC_OFF);
    F.tid = threadIdx.x; F.lane = F.tid & 63; F.wave = __builtin_amdgcn_readfirstlane(F.tid >> 6);
    F.G = gridDim.x; { const int bx = blockIdx.x; F.vcu = (F.G % 8 == 0) ? (bx % 8) * (F.G / 8) + bx / 8 : bx; }
    unsigned char* ws = args.ws;
    F.ctl = (gu32*)(ws + WS_CTL);
    F.a = &args; F.ws = ws; F.out = args.out;
    for (int u = F.tid; u < (LDS_BYTES - LDSCTL_OFF) / 4; u += NWAVES * 64) ((LAS unsigned*)(F.lds + LDSCTL_OFF))[u] = 0u;
    __syncthreads();
    XcdBarrier bar; bar.bar = (unsigned*)(F.ctl + CW_BAR); bar.x = 0; bar.st = nullptr;
    if (N_LAUNCHES == 1) bar = xcd_barrier_post((unsigned*)(F.ctl + CW_BAR), F.MISC + 8);
#define GRID_BAR() do { if (N_LAUNCHES == 1) xcd_barrier(bar); } while (0)
    const int lo = args.ph_lo, hi = args.ph_hi;
#define IN(k) (lo <= (k) && (k) < hi)
#define BOTH(k) (IN(k) && IN((k) + 1))
#define PHASE_REFRESH() do { int t_ = threadIdx.x; asm volatile("" : "+v"(t_)); F.tid = t_; F.lane = t_ & 63; F.wave = __builtin_amdgcn_readfirstlane(t_ >> 6); } while (0)
    typedef pg8::StaticOrder SO;

    if (IN(0)) { PHASE_REFRESH(); p0_prologue(F); if (BOTH(0)) GRID_BAR(); }
    if (IN(1)) { PHASE_REFRESH(); norm_rows(F, p_x(F), 0); if (BOTH(1)) GRID_BAR(); }
    if (IN(2)) { PHASE_REFRESH(); pg8::Gemm g{p_XN(F), p_WGU1(F), M, NGU, D}; SO S; S.init(M, NGU, F.G, (int)blockIdx.x); pg8::EpiSwiGLU E{p_H(F), FF};
        pg8::gemm_phase<pg8::EpiSwiGLU, SO, PG8_ALIGN, PG8_SP2>(F.lds + RING_OFF, g, S, E);
        { const int nfull = (M / 256) * (NGU / 256) % F.G; if (nfull != 0) { if ((int)blockIdx.x >= nfull) p2_tail_convert(F, nfull); } else if (F.G > 0) p2_tail_convert(F, 0); }
        if (BOTH(2)) GRID_BAR(); }
    if (IN(3)) { PHASE_REFRESH(); pg8::Gemm g{p_H(F), p_WD1(F), M, D, FF}; SO S; S.init(M, D, F.G, (int)blockIdx.x); pg8::EpiResGate<false, true, 2> E{p_x(F), p_X1B(F), p_MOD(F)};
        pg8::gemm_phase<pg8::EpiResGate<false, true, 2>, SO, PG8_ALIGN, PG8_SP2>(F.lds + RING_OFF, g, S, E); if (BOTH(3)) GRID_BAR(); }
    if (IN(4)) { PHASE_REFRESH(); norm_rows_b16<NR4>(F, p_X1B(F), 1); if (BOTH(4)) GRID_BAR(); }
    if (IN(5)) { PHASE_REFRESH(); pg8::Gemm g{p_XN(F), p_WINA(F), M, NINA, D}; SO S; S.init(M, NINA, F.G, (int)blockIdx.x); pg8::EpiInA E{p_Q(F), p_K(F), p_V(F), p_U(F), p_GV(F), p_q_g(F), p_k_g(F), p_GVSTAT(F), QSCALE};
        pg8::gemm_phase<pg8::EpiInA, SO, PG8_ALIGN, PG8_SP2>(F.lds + RING_OFF, g, S, E); if (BOTH(5)) GRID_BAR(); }
    if (IN(7)) { PHASE_REFRESH();
        for (int p = F.vcu; p < 256; p += F.G) { const int bh = p >> 2; attn_units(F, bh >> 3, bh & 7, p & 3); }
        gmlp_units(F, F.vcu, F.G);
        __syncthreads();
        if (BOTH(7)) GRID_BAR(); }
    if (IN(8)) { PHASE_REFRESH(); pg8::Gemm g{p_XN(F), p_WING(F), M, NING, D}; pg8::GateOrder S; S.init(M, D, F.G, (int)blockIdx.x); pg8::EpiGate E{p_K(F), p_V(F)};
        pg8::gemm_phase<pg8::EpiGate, pg8::GateOrder, PG8_ALIGN, PG8_SP2>(F.lds + RING_OFF, g, S, E); }
    if (IN(9)) { PHASE_REFRESH(); SO S; S.init(M, D, F.G, (int)blockIdx.x);
        { pg8::Gemm g{p_Q(F), p_WA(F), M, D, D}; pg8::EpiProj<false> E{p_K(F), p_GV(F)}; pg8::gemm_phase<pg8::EpiProj<false>, SO, PG8_ALIGN, PG8_SP2>(F.lds + RING_OFF, g, S, E); }
        { pg8::Gemm g{p_U(F), p_WB(F), M, D, D}; pg8::EpiProj<true> E{p_V(F), p_GV(F)}; pg8::gemm_phase<pg8::EpiProj<true>, SO, PG8_ALIGN, PG8_SP2>(F.lds + RING_OFF, g, S, E); }
        if (BOTH(9)) GRID_BAR(); }
    if (IN(10)) { PHASE_REFRESH(); pg8::Gemm g{p_GV(F), p_WO(F), M, D, D}; SO S; S.init(M, D, F.G, (int)blockIdx.x); pg8::EpiResGate<true, true, 5> E{p_X1B(F), p_X2B(F), p_MOD(F)};
        pg8::gemm_phase<pg8::EpiResGate<true, true, 5>, SO, PG8_ALIGN, PG8_SP2>(F.lds + RING_OFF, g, S, E); if (BOTH(10)) GRID_BAR(); }
    if (IN(11)) { PHASE_REFRESH(); norm_rows_b16<NR11>(F, p_X2B(F), 2); if (BOTH(11)) GRID_BAR(); }
    if (IN(12)) { PHASE_REFRESH(); pg8::Gemm g{p_XN(F), p_WGU2(F), M, NGU, D}; SO S; S.init(M, NGU, F.G, (int)blockIdx.x); pg8::EpiSwiGLU E{p_H(F), FF};
        pg8::gemm_phase<pg8::EpiSwiGLU, SO, PG8_ALIGN, PG8_SP2>(F.lds + RING_OFF, g, S, E);
        { const int nfull = (M / 256) * (NGU / 256) % F.G; if (nfull != 0) { if ((int)blockIdx.x >= nfull) p12_tail_convert(F, nfull); } else p12_tail_convert(F, 0); }
        if (BOTH(12)) GRID_BAR(); }
    if (IN(13)) { PHASE_REFRESH(); pg8::Gemm g{p_H(F), p_WD2(F), M, D, FF}; SO S; S.init(M, D, F.G, (int)blockIdx.x); pg8::EpiResGate<true, false, 8> E{p_X2B(F), F.out, p_MOD(F)};
        pg8::gemm_phase<pg8::EpiResGate<true, false, 8>, SO, PG8_ALIGN, PG8_SP2>(F.lds + RING_OFF, g, S, E); }
#undef IN
#undef BOTH
}

extern "C" void kernel_launch(void* const* d_in, const int* in_sizes, int n_in, void* d_out, int out_size, void* d_ws, size_t ws_size, hipStream_t stream) {
    static int grid = 0;
    if (grid == 0) {
        if (n_in != 26 || in_sizes[0] != M * D || out_size != M * D || ws_size < WS_END) { fprintf(stderr, "kernel_launch: unexpected problem (n_in %d, in0 %d, out %d, ws %zu)\n", n_in, n_in > 0 ? in_sizes[0] : -1, out_size, ws_size); grid = -1; return; }
        int dev = 0, cus = 0;
        if (hipGetDevice(&dev) != hipSuccess || hipDeviceGetAttribute(&cus, hipDeviceAttributeMultiprocessorCount, dev) != hipSuccess) { grid = -1; return; }
        if (hipFuncSetAttribute((const void*)mk_fwd, hipFuncAttributeMaxDynamicSharedMemorySize, LDS_BYTES) != hipSuccess) { fprintf(stderr, "kernel_launch: hipFuncSetAttribute failed\n"); grid = -1; return; }
        int per_cu = 0;
        if (hipOccupancyMaxActiveBlocksPerMultiprocessor(&per_cu, (const void*)mk_fwd, NWAVES * 64, LDS_BYTES) != hipSuccess || per_cu < 1) fprintf(stderr, "kernel_launch: occupancy query says %d\n", per_cu);
        (void)hipGetLastError();
        grid = cus;
    }
    if (grid < 0) return;
    if (hipMemsetAsync((char*)d_ws + WS_CTL, 0, CTL_ZERO_BYTES, stream) != hipSuccess) return;
    Args a{};
    for (int i = 0; i < 26; ++i) a.in[i] = (const float*)d_in[i];
    a.out = (float*)d_out; a.ws = (unsigned char*)d_ws;
    for (int li = 0; li < N_LAUNCHES; ++li) {
        a.ph_lo = (N_LAUNCHES == 1) ? 0 : li; a.ph_hi = (N_LAUNCHES == 1) ? N_PHASES : li + 1; a.li = li;
        hipLaunchKernelGGL(mk_fwd, dim3(grid), dim3(NWAVES * 64), LDS_BYTES, stream, a);
    }
}
```
